# Optimizing an MI355X kernel written in HIP

```python
import math
import jax, jax.numpy as jnp
from jax import lax
import numpy as np

D_MODEL = 2048
BATCH = 4
SEQ = 4096
DEPTH = 2

PLE_DIM = 256
D_FF = 5632
ALPHA = (2 * DEPTH) ** 0.25
BETA = (8 * DEPTH) ** -0.25
Q_BLOCK = 128
ROPE_THETA = 10000.0
NEG_INF = -1e30
LN_EPS = 1e-5
RMS_EPS = 1e-6

S5_WIDTH = 512
S5_GROUP = 16
S5_GROUPS = S5_WIDTH // S5_GROUP
S5_STATE = 64
S5_DT_MIN = 1e-3
S5_DT_MAX = 1e-1

MLA_HEADS = 4
MLA_Q_RANK = 512
MLA_KV_RANK = 128
MLA_NOPE = 128
MLA_ROPE = 64
MLA_V = 128

RET_HEADS = 4
RET_QK = 64
RET_V = 128
RET_CHUNK = 128

DIFF_HEADS = 4
DIFF_QK = 64
DIFF_V = 128

T5_BUCKETS = 32
T5_MAX_DIST = 128

IN_SPLIT_SIZES = (S5_WIDTH, MLA_Q_RANK, MLA_KV_RANK, MLA_ROPE,
                  RET_HEADS * RET_QK, RET_HEADS * RET_QK, RET_HEADS * RET_V, RET_HEADS * RET_V,
                  DIFF_HEADS * 2 * DIFF_QK, DIFF_HEADS * 2 * DIFF_QK, DIFF_HEADS * DIFF_V)
IN_WIDTH = sum(IN_SPLIT_SIZES)
MIX_WIDTH = S5_WIDTH + MLA_HEADS * MLA_V + RET_HEADS * RET_V + DIFF_HEADS * DIFF_V

kernel_name = 'hybrid_s5_mla_retention_diffattn_deepnorm'

F32 = jnp.float32


def layer_norm(x, g, b):
    xf = x.astype(F32)
    mu = jnp.mean(xf, -1, keepdims=True)
    var = jnp.mean(jnp.square(xf - mu), -1, keepdims=True)
    return ((xf - mu) * lax.rsqrt(var + LN_EPS) * g.astype(F32) + b.astype(F32)).astype(x.dtype)


def rms_norm(x, g):
    xf = x.astype(F32)
    xf = xf * lax.rsqrt(jnp.mean(jnp.square(xf), -1, keepdims=True) + RMS_EPS)
    return (xf * g.astype(F32)).astype(x.dtype)


def swiglu(x, w_gate, w_up, w_down):
    return (jax.nn.silu(x @ w_gate) * (x @ w_up)) @ w_down


def rope_cos_sin(positions, dim):
    inv_freq = 1.0 / (ROPE_THETA ** (jnp.arange(0, dim, 2, dtype=F32) / dim))
    ang = positions.astype(F32)[..., None] * inv_freq
    return jnp.cos(ang)[:, :, None, :], jnp.sin(ang)[:, :, None, :]


def apply_rope(x, cos, sin):
    x1, x2 = jnp.split(x.astype(F32), 2, axis=-1)
    return jnp.concatenate([x1 * cos - x2 * sin, x1 * sin + x2 * cos], -1).astype(x.dtype)


def t5_bucket(dist):
    n = jnp.maximum(dist, 0)
    max_exact = T5_BUCKETS // 2
    nf = jnp.maximum(n, 1).astype(F32)
    large = max_exact + (jnp.log(nf / max_exact) / math.log(T5_MAX_DIST / max_exact)
                         * (T5_BUCKETS - max_exact)).astype(jnp.int32)
    large = jnp.minimum(large, T5_BUCKETS - 1)
    return jnp.where(n < max_exact, n, large)


def causal_block_sweep(block_fn, n_pos):
    out = lax.map(block_fn, jnp.arange(n_pos // Q_BLOCK))
    out = jnp.moveaxis(out, 0, 1)
    return out.reshape(out.shape[0], n_pos, out.shape[3], out.shape[4])


def complex_linear_combine(e1, e2):
    a1r, a1i, b1r, b1i = e1
    a2r, a2i, b2r, b2i = e2
    return (a2r * a1r - a2i * a1i,
            a2r * a1i + a2i * a1r,
            a2r * b1r - a2i * b1i + b2r,
            a2r * b1i + a2i * b1r + b2i)


def s5_mixer(u, lam_re, lam_im, log_dt, b_re, b_im, c_re, c_im, d, w_glu, b_glu):
    bsz, n_pos, _ = u.shape
    uf = u.astype(F32).reshape(bsz, n_pos, S5_GROUPS, S5_GROUP)
    lr = lam_re.astype(F32)
    li = lam_im.astype(F32)
    dt = jnp.exp(log_dt.astype(F32))[:, None]
    mag = jnp.exp(lr * dt)
    ar = mag * jnp.cos(li * dt)
    ai = mag * jnp.sin(li * dt)
    den = lr * lr + li * li
    fr = ((ar - 1.0) * lr + ai * li) / den
    fi = (ai * lr - (ar - 1.0) * li) / den
    br = b_re.astype(F32)
    bi = b_im.astype(F32)
    bbr = fr[..., None] * br - fi[..., None] * bi
    bbi = fr[..., None] * bi + fi[..., None] * br
    bu_r = jnp.einsum('bsgc,gpc->bsgp', uf, bbr)
    bu_i = jnp.einsum('bsgc,gpc->bsgp', uf, bbi)
    a_r = jnp.broadcast_to(ar, bu_r.shape)
    a_i = jnp.broadcast_to(ai, bu_i.shape)
    _, _, h_r, h_i = lax.associative_scan(complex_linear_combine, (a_r, a_i, bu_r, bu_i), axis=1)
    y = (jnp.einsum('bsgp,gcp->bsgc', h_r, c_re.astype(F32))
         - jnp.einsum('bsgp,gcp->bsgc', h_i, c_im.astype(F32))
         + d.astype(F32).reshape(S5_GROUPS, S5_GROUP) * uf)
    y = jax.nn.gelu(y.reshape(bsz, n_pos, S5_WIDTH)).astype(u.dtype)
    return y * jax.nn.sigmoid(y @ w_glu + b_glu)


def mla_mixer(c_q, c_kv, k_r, cos, sin, q_norm_g, w_uq, kv_norm_g, w_ukv):
    bsz, n_pos, _ = c_q.shape
    q = (rms_norm(c_q, q_norm_g) @ w_uq).reshape(bsz, n_pos, MLA_HEADS, MLA_NOPE + MLA_ROPE)
    q = jnp.concatenate([q[..., :MLA_NOPE], apply_rope(q[..., MLA_NOPE:], cos, sin)], -1)
    kv = (rms_norm(c_kv, kv_norm_g) @ w_ukv).reshape(bsz, n_pos, MLA_HEADS, MLA_NOPE + MLA_V)
    k_rope = apply_rope(k_r[:, :, None, :], cos, sin)
    k = jnp.concatenate([kv[..., :MLA_NOPE],
                         jnp.broadcast_to(k_rope, (bsz, n_pos, MLA_HEADS, MLA_ROPE))], -1)
    v = kv[..., MLA_NOPE:]
    scale = (MLA_NOPE + MLA_ROPE) ** -0.5
    key_idx = jnp.arange(n_pos)

    def block(i):
        start = i * Q_BLOCK
        qb = lax.dynamic_slice_in_dim(q, start, Q_BLOCK, axis=1)
        s = jnp.einsum('bqhd,bkhd->bhqk', qb, k).astype(F32) * scale
        causal = (start + jnp.arange(Q_BLOCK))[:, None] >= key_idx[None, :]
        pr = jax.nn.softmax(jnp.where(causal, s, NEG_INF), axis=-1)
        return jnp.einsum('bhqk,bkhd->bqhd', pr.astype(v.dtype), v)

    return causal_block_sweep(block, n_pos).reshape(bsz, n_pos, MLA_HEADS * MLA_V)


def retention_mixer(q, k, v, g, cos, sin):
    bsz, n_pos, _ = q.shape
    n_chunks = n_pos // RET_CHUNK
    q = apply_rope(q.reshape(bsz, n_pos, RET_HEADS, RET_QK), cos, sin).astype(F32)
    k = apply_rope(k.reshape(bsz, n_pos, RET_HEADS, RET_QK), cos, sin).astype(F32) * (RET_QK ** -0.5)
    v = v.reshape(bsz, n_pos, RET_HEADS, RET_V).astype(F32)
    log_gamma = jnp.log(1.0 - jnp.power(2.0, -5.0 - jnp.arange(RET_HEADS, dtype=F32)))
    idx = jnp.arange(RET_CHUNK, dtype=F32)
    rel = idx[:, None] - idx[None, :]
    intra = jnp.where(rel >= 0, jnp.exp(log_gamma[:, None, None] * jnp.maximum(rel, 0.0)), 0.0)
    qc = q.reshape(bsz, n_chunks, RET_CHUNK, RET_HEADS, RET_QK)
    kc = k.reshape(bsz, n_chunks, RET_CHUNK, RET_HEADS, RET_QK)
    vc = v.reshape(bsz, n_chunks, RET_CHUNK, RET_HEADS, RET_V)
    scores = jnp.einsum('bnihd,bnjhd->bnhij', qc, kc) * intra
    inner = jnp.einsum('bnhij,bnjhv->bnihv', scores, vc)
    k_decay = jnp.exp(log_gamma[None, :] * (RET_CHUNK - 1 - idx)[:, None])
    kv = jnp.einsum('bnjhd,jh,bnjhv->bnhdv', kc, k_decay, vc)
    chunk_decay = jnp.exp(log_gamma * RET_CHUNK)[:, None, None]

    def step(state, kv_n):
        return state * chunk_decay + kv_n, state

    _, prev = lax.scan(step, jnp.zeros((bsz, RET_HEADS, RET_QK, RET_V), F32), jnp.moveaxis(kv, 1, 0))
    prev = jnp.moveaxis(prev, 0, 1)
    q_decay = jnp.exp(log_gamma[None, :] * (idx + 1.0)[:, None])
    cross = jnp.einsum('bnihd,ih,bnhdv->bnihv', qc, q_decay, prev)
    o = (inner + cross).reshape(bsz, n_pos, RET_HEADS, RET_V)
    mu = jnp.mean(o, -1, keepdims=True)
    var = jnp.mean(jnp.square(o - mu), -1, keepdims=True)
    o = (o - mu) * lax.rsqrt(var + LN_EPS)
    return (jax.nn.silu(g.astype(F32)) * o.reshape(bsz, n_pos, RET_HEADS * RET_V)).astype(g.dtype)


def diff_mixer(q, k, v, positions, rel_bias, lq1, lk1, lq2, lk2, subln_g, lambda_init):
    bsz, n_pos, _ = q.shape
    q = q.reshape(bsz, n_pos, DIFF_HEADS, 2, DIFF_QK)
    k = k.reshape(bsz, n_pos, DIFF_HEADS, 2, DIFF_QK)
    v = v.reshape(bsz, n_pos, DIFF_HEADS, DIFF_V)
    lam = (jnp.exp(jnp.sum(lq1.astype(F32) * lk1.astype(F32)))
           - jnp.exp(jnp.sum(lq2.astype(F32) * lk2.astype(F32))) + lambda_init)
    scale = DIFF_QK ** -0.5
    key_idx = jnp.arange(n_pos)
    table = rel_bias.astype(F32)

    def block(i):
        start = i * Q_BLOCK
        qb = lax.dynamic_slice_in_dim(q, start, Q_BLOCK, axis=1)
        pos_q = lax.dynamic_slice_in_dim(positions, start, Q_BLOCK, axis=1)
        bucket = t5_bucket(pos_q[:, :, None] - positions[:, None, :])
        bias = jnp.transpose(jnp.take(table, bucket, axis=0), (0, 3, 1, 2))
        s = jnp.einsum('bqhmd,bkhmd->bhmqk', qb, k).astype(F32) * scale + bias[:, :, None]
        causal = (start + jnp.arange(Q_BLOCK))[:, None] >= key_idx[None, :]
        pr = jax.nn.softmax(jnp.where(causal, s, NEG_INF), axis=-1)
        a = pr[:, :, 0] - lam * pr[:, :, 1]
        return jnp.einsum('bhqk,bkhd->bqhd', a.astype(v.dtype), v)

    o = causal_block_sweep(block, n_pos)
    o = rms_norm(o, subln_g) * (1.0 - lambda_init)
    return o.reshape(bsz, n_pos, DIFF_HEADS * DIFF_V)


def setup_inputs(seed: int = 0) -> dict:
    key = jax.random.key(seed)
    ks = list(jax.random.split(key, 64))
    ctr = [0]

    def nk():
        ctr[0] += 1
        return ks[ctr[0] - 1]

    def nrm(shape, scale):
        return scale * jax.random.normal(nk(), shape, F32)

    def gain(shape):
        return 1.0 + nrm(shape, 0.02)

    L, D, F = DEPTH, D_MODEL, D_FF
    G, P = S5_GROUPS, S5_STATE
    x = nrm((BATCH, SEQ, D), 1.0)
    p = nrm((L, BATCH, SEQ, PLE_DIM), 1.0)
    offsets = jax.random.randint(nk(), (BATCH, 1), 0, 1024, jnp.int32)
    positions = offsets + jnp.arange(SEQ, dtype=jnp.int32)[None, :]
    rel_bias = nrm((T5_BUCKETS, DIFF_HEADS), 0.5)
    ffn1_w_gate = nrm((L, D, F), D ** -0.5)
    ffn1_w_up = nrm((L, D, F), D ** -0.5)
    ffn1_w_down = nrm((L, F, D), BETA * F ** -0.5)
    ln1_g = gain((L, D))
    ln1_b = nrm((L, D), 0.02)
    w_in = nrm((L, D, IN_WIDTH), D ** -0.5)
    w_out = nrm((L, MIX_WIDTH, D), BETA * MIX_WIDTH ** -0.5)
    ln2_g = gain((L, D))
    ln2_b = nrm((L, D), 0.02)
    s5_lambda_re = -0.5 + nrm((L, G, P), 0.01)
    s5_lambda_im = jnp.pi * jnp.arange(P, dtype=F32)[None, None, :] + nrm((L, G, P), 0.01)
    s5_log_dt = jax.random.uniform(nk(), (L, G), F32, math.log(S5_DT_MIN), math.log(S5_DT_MAX))
    s5_b_re = nrm((L, G, P, S5_GROUP), (2.0 * S5_GROUP) ** -0.5)
    s5_b_im = nrm((L, G, P, S5_GROUP), (2.0 * S5_GROUP) ** -0.5)
    s5_c_re = nrm((L, G, S5_GROUP, P), (2.0 * P) ** -0.5)
    s5_c_im = nrm((L, G, S5_GROUP, P), (2.0 * P) ** -0.5)
    s5_d = nrm((L, S5_WIDTH), 1.0)
    s5_w_glu = nrm((L, S5_WIDTH, S5_WIDTH), S5_WIDTH ** -0.5)
    s5_b_glu = nrm((L, S5_WIDTH), 0.02)
    mla_q_norm_g = gain((L, MLA_Q_RANK))
    mla_w_uq = nrm((L, MLA_Q_RANK, MLA_HEADS * (MLA_NOPE + MLA_ROPE)), MLA_Q_RANK ** -0.5)
    mla_kv_norm_g = gain((L, MLA_KV_RANK))
    mla_w_ukv = nrm((L, MLA_KV_RANK, MLA_HEADS * (MLA_NOPE + MLA_V)), MLA_KV_RANK ** -0.5)
    diff_lambda_q1 = nrm((L, DIFF_QK), 0.1)
    diff_lambda_k1 = nrm((L, DIFF_QK), 0.1)
    diff_lambda_q2 = nrm((L, DIFF_QK), 0.1)
    diff_lambda_k2 = nrm((L, DIFF_QK), 0.1)
    diff_subln_g = gain((L, DIFF_V))
    ffn2_w_gate = nrm((L, D, F), D ** -0.5)
    ffn2_w_up = nrm((L, D, F), D ** -0.5)
    ffn2_w_down = nrm((L, F, D), BETA * F ** -0.5)
    ple_w_gate = nrm((L, D, D), D ** -0.5)
    ple_b_gate = nrm((L, D), 0.02)
    ple_w_proj = nrm((L, PLE_DIM, D), BETA * PLE_DIM ** -0.5)
    ln3_g = gain((L, D))
    ln3_b = nrm((L, D), 0.02)
    return {'x': x, 'p': p, 'positions': positions, 'rel_bias': rel_bias,
            'ffn1_w_gate': ffn1_w_gate, 'ffn1_w_up': ffn1_w_up, 'ffn1_w_down': ffn1_w_down,
            'ln1_g': ln1_g, 'ln1_b': ln1_b, 'w_in': w_in, 'w_out': w_out,
            'ln2_g': ln2_g, 'ln2_b': ln2_b,
            's5_lambda_re': s5_lambda_re, 's5_lambda_im': s5_lambda_im, 's5_log_dt': s5_log_dt,
            's5_b_re': s5_b_re, 's5_b_im': s5_b_im, 's5_c_re': s5_c_re, 's5_c_im': s5_c_im,
            's5_d': s5_d, 's5_w_glu': s5_w_glu, 's5_b_glu': s5_b_glu,
            'mla_q_norm_g': mla_q_norm_g, 'mla_w_uq': mla_w_uq,
            'mla_kv_norm_g': mla_kv_norm_g, 'mla_w_ukv': mla_w_ukv,
            'diff_lambda_q1': diff_lambda_q1, 'diff_lambda_k1': diff_lambda_k1,
            'diff_lambda_q2': diff_lambda_q2, 'diff_lambda_k2': diff_lambda_k2,
            'diff_subln_g': diff_subln_g,
            'ffn2_w_gate': ffn2_w_gate, 'ffn2_w_up': ffn2_w_up, 'ffn2_w_down': ffn2_w_down,
            'ple_w_gate': ple_w_gate, 'ple_b_gate': ple_b_gate, 'ple_w_proj': ple_w_proj,
            'ln3_g': ln3_g, 'ln3_b': ln3_b}


def reference(x, p, positions, rel_bias,
              ffn1_w_gate, ffn1_w_up, ffn1_w_down, ln1_g, ln1_b, w_in, w_out,
              ln2_g, ln2_b,
              s5_lambda_re, s5_lambda_im, s5_log_dt, s5_b_re, s5_b_im, s5_c_re, s5_c_im,
              s5_d, s5_w_glu, s5_b_glu,
              mla_q_norm_g, mla_w_uq, mla_kv_norm_g, mla_w_ukv,
              diff_lambda_q1, diff_lambda_k1, diff_lambda_q2, diff_lambda_k2, diff_subln_g,
              ffn2_w_gate, ffn2_w_up, ffn2_w_down, ple_w_gate, ple_b_gate, ple_w_proj,
              ln3_g, ln3_b):
    cos_m, sin_m = rope_cos_sin(positions, MLA_ROPE)
    cos_r, sin_r = rope_cos_sin(positions, RET_QK)
    split_points = [int(c) for c in np.cumsum(IN_SPLIT_SIZES)[:-1]]
    for i in range(DEPTH):
        h = 0.5 * swiglu(x, ffn1_w_gate[i], ffn1_w_up[i], ffn1_w_down[i])
        x = layer_norm(ALPHA * x + h, ln1_g[i], ln1_b[i])
        (s5_u, mla_cq, mla_ckv, mla_kr, ret_q, ret_k, ret_v, ret_g,
         diff_q, diff_k, diff_v) = jnp.split(x @ w_in[i], split_points, axis=-1)
        y_s5 = s5_mixer(s5_u, s5_lambda_re[i], s5_lambda_im[i], s5_log_dt[i], s5_b_re[i], s5_b_im[i],
                        s5_c_re[i], s5_c_im[i], s5_d[i], s5_w_glu[i], s5_b_glu[i])
        y_mla = mla_mixer(mla_cq, mla_ckv, mla_kr, cos_m, sin_m, mla_q_norm_g[i], mla_w_uq[i],
                          mla_kv_norm_g[i], mla_w_ukv[i])
        y_ret = retention_mixer(ret_q, ret_k, ret_v, ret_g, cos_r, sin_r)
        lambda_init = 0.8 - 0.6 * math.exp(-0.3 * i)
        y_diff = diff_mixer(diff_q, diff_k, diff_v, positions, rel_bias, diff_lambda_q1[i],
                            diff_lambda_k1[i], diff_lambda_q2[i], diff_lambda_k2[i],
                            diff_subln_g[i], lambda_init)
        mix = jnp.concatenate([y_s5, y_mla.astype(x.dtype), y_ret.astype(x.dtype),
                               y_diff.astype(x.dtype)], axis=-1) @ w_out[i]
        x = layer_norm(ALPHA * x + mix, ln2_g[i], ln2_b[i])
        gate = jax.nn.sigmoid(x @ ple_w_gate[i] + ple_b_gate[i])
        h = 0.5 * swiglu(x, ffn2_w_gate[i], ffn2_w_up[i], ffn2_w_down[i]) + gate * (p[i] @ ple_w_proj[i])
        x = layer_norm(ALPHA * x + h, ln3_g[i], ln3_b[i])
    return x
```

```cpp
#include <hip/hip_runtime.h>
#include <hip/hip_cooperative_groups.h>
#include <cstdio>
#include <cstdint>
namespace cg = cooperative_groups;

#ifndef ONE_LAUNCH
#define ONE_LAUNCH 1
#endif

#ifndef PROBE_DUP
#define PROBE_DUP 0
#endif
#define LAS __attribute__((address_space(3)))
typedef unsigned short bf16_t;
typedef short bf16x8 __attribute__((ext_vector_type(8)));
typedef short s16x4 __attribute__((ext_vector_type(4)));
typedef float f32x4 __attribute__((ext_vector_type(4)));
typedef float f32x16 __attribute__((ext_vector_type(16)));
typedef unsigned u32x4 __attribute__((ext_vector_type(4)));
typedef unsigned u32x2 __attribute__((ext_vector_type(2)));
typedef float f32x2_t __attribute__((ext_vector_type(2)));
typedef __bf16 bf16x2_t __attribute__((ext_vector_type(2)));
typedef LAS const char* lds_cptr;

constexpr int BATCH = 4, SEQ = 4096, T = BATCH * SEQ, DM = 2048, DFF = 5632, DEPTH = 2, PLE = 256;
constexpr int INW = 4288, INWP = 4352;
constexpr int C_S5 = 0, C_CQ = 512, C_CKV = 1024, C_KR = 1152, C_RQ = 1216, C_RK = 1472, C_RV = 1728, C_RG = 2240, C_DQ = 2752, C_DK = 3264, C_DV = 3776;
constexpr float ALPHA = 1.41421356237309515f;
constexpr float LOG2E = 1.4426950408889634f;

__device__ __forceinline__ unsigned cvt_pk(float lo, float hi) { f32x2_t v = {lo, hi}; bf16x2_t b = __builtin_convertvector(v, bf16x2_t); return __builtin_bit_cast(unsigned, b); }
__device__ __forceinline__ float bf2f(unsigned short h) { return __uint_as_float(((unsigned)h) << 16); }
__device__ __forceinline__ float bflo(unsigned w) { return __uint_as_float(w << 16); }
__device__ __forceinline__ float bfhi(unsigned w) { return __uint_as_float(w & 0xffff0000u); }
__device__ __forceinline__ unsigned short f2bf(float f) { return (unsigned short)(cvt_pk(f, 0.f) & 0xffffu); }
__device__ __forceinline__ float wave_sum(float v) {
    v += __builtin_bit_cast(float, __builtin_amdgcn_update_dpp(0, __builtin_bit_cast(int, v), 0x111, 0xf, 0xf, true));
    v += __builtin_bit_cast(float, __builtin_amdgcn_update_dpp(0, __builtin_bit_cast(int, v), 0x112, 0xf, 0xf, true));
    v += __builtin_bit_cast(float, __builtin_amdgcn_update_dpp(0, __builtin_bit_cast(int, v), 0x114, 0xf, 0xf, true));
    v += __builtin_bit_cast(float, __builtin_amdgcn_update_dpp(0, __builtin_bit_cast(int, v), 0x118, 0xf, 0xf, true));
    v += __builtin_bit_cast(float, __builtin_amdgcn_update_dpp(0, __builtin_bit_cast(int, v), 0x142, 0xa, 0xf, false));
    v += __builtin_bit_cast(float, __builtin_amdgcn_update_dpp(0, __builtin_bit_cast(int, v), 0x143, 0xc, 0xf, false));
    return __builtin_bit_cast(float, __builtin_amdgcn_readlane(__builtin_bit_cast(int, v), 63));
}
__device__ __forceinline__ float fast_exp2(float x) { return __builtin_amdgcn_exp2f(x); }
__device__ __forceinline__ float fast_rcp(float x) { return __builtin_amdgcn_rcpf(x); }
__device__ __forceinline__ float sigmoidf_(float x) { return fast_rcp(1.f + fast_exp2(-x * LOG2E)); }

namespace pg8 {
constexpr int BM = 256, BK = 64, HALF = 128, HTB = HALF * BK * 2, STAGE_BYTES = 8 * HTB, NXCD = 8, WGM = 8;
__host__ __device__ __forceinline__ int lds_byte(int r, int c) { const int st = (r >> 4) * 2 + (c >> 5), rr = r & 15, cc = c & 31, ob = rr * 64 + cc * 2; return st * 1024 + (ob ^ (((ob >> 9) & 1) << 5)); }
__host__ __device__ __forceinline__ void stage_rc(int b, int& R, int& C) { const int st = b / 1024, sb = b % 1024, swz = sb ^ (((sb >> 9) & 1) << 5); R = (st >> 1) * 16 + swz / 64; C = (st & 1) * 32 + (swz % 64) / 2; }
__host__ __device__ __forceinline__ int perm32(int rho) { const int n = rho >> 4, i = rho & 15; return 8 * (i >> 2) + 4 * n + (i & 3); }
struct Unit { int pm, pn; };
struct Gemm { const bf16_t* A; const bf16_t* Bt; int M, N, K, lda; };
struct StaticOrder {
    int nM, nN, nwg, G, c;
    __device__ void init(int M, int N, int G_, int c_) { nM = M / BM; nN = N / BM; nwg = nM * nN; G = G_; c = c_; }
    __device__ bool next(int i, Unit& u) const {
        const long L = (long)i * G + c; if (L >= nwg) return false;
        int wgid = (int)L; { const int q = nwg / NXCD, r = nwg % NXCD, xcd = wgid % NXCD, off = wgid / NXCD; wgid = (xcd < r ? xcd * (q + 1) : r * (q + 1) + (xcd - r) * q) + off; }
        const int nig = WGM * nN, gid = wgid / nig, fm = gid * WGM, gsz = (nM - fm) < WGM ? (nM - fm) : WGM;
        u.pm = fm + ((wgid % nig) % gsz); u.pn = (wgid % nig) / gsz; return true;
    }
};

struct EpiStore {
    static constexpr bool PERM = true;
    bf16_t* O; int ldc; const float* rs; int rs_stride; float cs;
    __device__ __forceinline__ void operator()(const f32x4 (&acc)[2][2][4][2], const Unit& u, int wr, int wc, int fr, int fq) const {
        const int row0 = u.pm * BM + wr * 64 + fr, col0 = u.pn * BM + wc * 32 + 8 * fq;
        float scv[2][4];
#pragma unroll
        for (int ai = 0; ai < 2; ++ai)
#pragma unroll
            for (int m = 0; m < 4; ++m) scv[ai][m] = rs ? rs[(size_t)(row0 + ai * HALF + m * 16) * rs_stride] * cs : cs;
#pragma unroll
        for (int ai = 0; ai < 2; ++ai)
#pragma unroll
            for (int m = 0; m < 4; ++m) {
                const int row = row0 + ai * HALF + m * 16; const float sc = scv[ai][m];
                bf16_t* rowp = O + (size_t)row * ldc + col0;
#pragma unroll
                for (int bj = 0; bj < 2; ++bj) { const f32x4 v0 = acc[ai][bj][m][0] * sc, v1 = acc[ai][bj][m][1] * sc;
                    u32x4 w; w.x = cvt_pk(v0[0], v0[1]); w.y = cvt_pk(v0[2], v0[3]); w.z = cvt_pk(v1[0], v1[1]); w.w = cvt_pk(v1[2], v1[3]);
                    *(u32x4*)(rowp + bj * HALF) = w; }
            }
    }
};
struct EpiSwiGLU {
    static constexpr bool PERM = true;
    bf16_t* ACT; bf16_t* PP; const float* bg; int n_swi;
    __device__ __forceinline__ void operator()(const f32x4 (&acc)[2][2][4][2], const Unit& u, int wr, int wc, int fr, int fq) const {
        const int row0 = u.pm * BM + wr * 64 + fr;
        if (u.pn < n_swi) {
            const int col0 = u.pn * HALF + wc * 32 + 8 * fq;
#pragma unroll
            for (int ai = 0; ai < 2; ++ai)
#pragma unroll
                for (int m = 0; m < 4; ++m) {
                    const int row = row0 + ai * HALF + m * 16; float a[8];
#pragma unroll
                    for (int n = 0; n < 2; ++n)
#pragma unroll
                        for (int i = 0; i < 4; ++i) { const float g = acc[ai][0][m][n][i], up = acc[ai][1][m][n][i]; a[n * 4 + i] = g * sigmoidf_(g) * up; }
                    u32x4 w; w.x = cvt_pk(a[0], a[1]); w.y = cvt_pk(a[2], a[3]); w.z = cvt_pk(a[4], a[5]); w.w = cvt_pk(a[6], a[7]);
                    *(u32x4*)(ACT + (size_t)row * DFF + col0) = w;
                }
        } else {
            const int colb = (u.pn - n_swi) * BM + wc * 32 + 8 * fq;
            f32x4 bv[2][2];
#pragma unroll
            for (int bj = 0; bj < 2; ++bj) { bv[bj][0] = *(const f32x4*)(bg + colb + bj * HALF); bv[bj][1] = *(const f32x4*)(bg + colb + bj * HALF + 4); }
#pragma unroll
            for (int ai = 0; ai < 2; ++ai) {
                u32x4 ppv[4][2];
#pragma unroll
                for (int m = 0; m < 4; ++m)
#pragma unroll
                    for (int bj = 0; bj < 2; ++bj) ppv[m][bj] = *(const u32x4*)(PP + (size_t)(row0 + ai * HALF + m * 16) * DM + colb + bj * HALF);
#pragma unroll
                for (int m = 0; m < 4; ++m) {
                    const int row = row0 + ai * HALF + m * 16;
#pragma unroll
                    for (int bj = 0; bj < 2; ++bj) {
                        const int c = colb + bj * HALF; bf16_t* pq = PP + (size_t)row * DM + c;
                        const u32x4 pp = ppv[m][bj];
                        const f32x4 a0 = acc[ai][bj][m][0] + bv[bj][0], a1 = acc[ai][bj][m][1] + bv[bj][1];
                        u32x4 w; w.x = cvt_pk(sigmoidf_(a0[0]) * bflo(pp.x), sigmoidf_(a0[1]) * bfhi(pp.x)); w.y = cvt_pk(sigmoidf_(a0[2]) * bflo(pp.y), sigmoidf_(a0[3]) * bfhi(pp.y));
                        w.z = cvt_pk(sigmoidf_(a1[0]) * bflo(pp.z), sigmoidf_(a1[1]) * bfhi(pp.z)); w.w = cvt_pk(sigmoidf_(a1[2]) * bflo(pp.w), sigmoidf_(a1[3]) * bfhi(pp.w));
                        *(u32x4*)pq = w;
                    }
                }
            }
        }
    }
};
struct EpiRes {
    static constexpr bool PERM = false;
    float* XF; float a, s;
    __device__ __forceinline__ void operator()(const f32x4 (&acc)[2][2][4][2], const Unit& u, int wr, int wc, int fr, int fq) const {
        const int row0 = u.pm * BM + wr * 64 + fr, col0 = u.pn * BM + wc * 32 + 4 * fq;
#pragma unroll
        for (int ai = 0; ai < 2; ++ai)
#pragma unroll
            for (int m = 0; m < 4; ++m) {
                float* rp = XF + (size_t)(row0 + ai * HALF + m * 16) * DM + col0;
#pragma unroll
                for (int bj = 0; bj < 2; ++bj)
#pragma unroll
                    for (int n = 0; n < 2; ++n) { float* p = rp + bj * HALF + n * 16; f32x4 x = *(const f32x4*)p; x = x * a + acc[ai][bj][m][n] * s; *(f32x4*)p = x; }
            }
    }
};

#ifndef PG8_ALIGN
#define PG8_ALIGN true
#endif
template <class Epi, bool ALIGN_EPI = PG8_ALIGN>
__device__ __forceinline__ void gemm_phase(LAS unsigned char* lds, const Gemm g, const StaticOrder& S, const Epi& E) {
    int tid = threadIdx.x; asm volatile("" : "+v"(tid));
    const int wid = __builtin_amdgcn_readfirstlane(tid >> 6), lane = tid & 63, wr = wid >> 2, wc = wid & 3, fr = lane & 15, fq = lane >> 4;
    int K = g.K; asm volatile("" : "+s"(K)); const int nt = K / BK, lda = g.lda;
    unsigned voffA[2], voffB[2];
#pragma unroll
    for (int i = 0; i < 2; ++i) { int R, C; stage_rc(tid * 16 + i * 8192, R, C); const int Rb = Epi::PERM ? ((R & ~31) + perm32(R & 31)) : R;
        voffA[i] = (unsigned)(R * lda + C) * 2u; voffB[i] = (unsigned)(Rb * K + C) * 2u; }
    const size_t kstep = (size_t)(BK * 2);
    const size_t hstepA = (size_t)HALF * lda * 2, hstepB = (size_t)HALF * K * 2;
    const size_t tstepA = 2 * hstepA, tstepB = 2 * hstepB;
    const unsigned ldsw = (unsigned)wid * 1024u;
    const int aoff = lds_byte(wr * 64 + fr, fq * 8), boff = lds_byte(wc * 32 + fr, fq * 8);
#define PG8_SA(b, h) (((b) * 2 + (h)) * HTB)
#define PG8_SB(b, h) ((4 + (b) * 2 + (h)) * HTB)
#define PG8_STAGE(bufoff, gbase, voff) do { _Pragma("unroll") for (int _i = 0; _i < 2; ++_i) \
        __builtin_amdgcn_global_load_lds((const unsigned*)((const char*)(gbase) + (voff)[_i]), (LAS unsigned*)(lds + (bufoff) + ldsw + _i * 8192), 16, 0, 0); } while (0)
#define PG8_LDA(dst, b, h) do { _Pragma("unroll") for (int m = 0; m < 4; ++m) _Pragma("unroll") for (int k = 0; k < 2; ++k) dst[m][k] = *(const LAS bf16x8*)(lds + PG8_SA(b, h) + aoff + m * 2048 + k * 1024); } while (0)
#define PG8_LDB(dst, b, h) do { _Pragma("unroll") for (int n = 0; n < 2; ++n) _Pragma("unroll") for (int k = 0; k < 2; ++k) dst[n][k] = *(const LAS bf16x8*)(lds + PG8_SB(b, h) + boff + n * 2048 + k * 1024); } while (0)
#define PG8_MMA(ai, bj, At, Bt) do { __builtin_amdgcn_s_setprio(1); _Pragma("unroll") for (int m = 0; m < 4; ++m) _Pragma("unroll") for (int n = 0; n < 2; ++n) _Pragma("unroll") for (int k = 0; k < 2; ++k) \
        acc[ai][bj][m][n] = __builtin_amdgcn_mfma_f32_16x16x32_bf16(Bt[n][k], At[m][k], acc[ai][bj][m][n], 0, 0, 0); __builtin_amdgcn_s_setprio(0); } while (0)
#define PG8_WAIT_V(n) asm volatile("s_waitcnt vmcnt(" #n ")" ::: "memory")
#define PG8_WAIT_L(n) asm volatile("s_waitcnt lgkmcnt(" #n ")" ::: "memory")
#define PG8_BAR __builtin_amdgcn_s_barrier()
#define PG8_SCHED __builtin_amdgcn_sched_barrier(0)
    Unit cur, nxt; int ui = 0;
    if (!S.next(0, cur)) return;
    f32x4 acc[2][2][4][2];
#pragma unroll
    for (int a = 0; a < 2; ++a)
#pragma unroll
        for (int b = 0; b < 2; ++b)
#pragma unroll
            for (int m = 0; m < 4; ++m)
#pragma unroll
                for (int n = 0; n < 2; ++n) acc[a][b][m][n] = (f32x4){0.f, 0.f, 0.f, 0.f};
    bf16x8 At[4][2], B0[2][2], B1[2][2];
    const char* cA = (const char*)g.A + (size_t)cur.pm * tstepA; const char* cB = (const char*)g.Bt + (size_t)cur.pn * tstepB;
    PG8_STAGE(PG8_SB(0, 0), cB, voffB); PG8_STAGE(PG8_SB(0, 1), cB + hstepB, voffB); PG8_STAGE(PG8_SA(0, 0), cA, voffA); PG8_STAGE(PG8_SA(0, 1), cA + hstepA, voffA);
    if (wr == 1) PG8_BAR;
    PG8_WAIT_V(2); PG8_BAR;
    PG8_STAGE(PG8_SB(1, 0), cB + kstep, voffB); PG8_STAGE(PG8_SA(1, 0), cA + kstep, voffA); PG8_STAGE(PG8_SB(1, 1), cB + hstepB + kstep, voffB);
    PG8_WAIT_V(6); PG8_BAR;
    for (;;) {
        const bool has_next = S.next(ui + 1, nxt);
        const char* nA = has_next ? (const char*)g.A + (size_t)nxt.pm * tstepA : cA; const char* nB = has_next ? (const char*)g.Bt + (size_t)nxt.pn * tstepB : cB;
        for (int t = 0; t < nt; t += 2) {
            const bool last = (t == nt - 2);
            const char* a1 = cA + (size_t)(t + 1) * kstep;
            const char* a2 = last ? nA : cA + (size_t)(t + 2) * kstep; const char* b2 = last ? nB : cB + (size_t)(t + 2) * kstep;
            const char* a3 = a2 + kstep; const char* b3 = b2 + kstep;
            PG8_LDB(B0, 0, 0); PG8_LDB(B1, 0, 1); PG8_SCHED; PG8_LDA(At, 0, 0); PG8_STAGE(PG8_SA(1, 1), a1 + hstepA, voffA);
            PG8_WAIT_V(8); PG8_WAIT_L(0); PG8_BAR; PG8_MMA(0, 0, At, B0); PG8_MMA(0, 1, At, B1); PG8_BAR; PG8_SCHED;
            PG8_LDA(At, 0, 1); PG8_STAGE(PG8_SB(0, 0), b2, voffB); PG8_STAGE(PG8_SB(0, 1), b2 + hstepB, voffB); PG8_STAGE(PG8_SA(0, 0), a2, voffA);
            PG8_WAIT_V(8); PG8_WAIT_L(0); PG8_BAR; PG8_MMA(1, 0, At, B0); PG8_MMA(1, 1, At, B1); PG8_BAR; PG8_SCHED;
            PG8_LDB(B0, 1, 0); PG8_LDB(B1, 1, 1); PG8_SCHED; PG8_LDA(At, 1, 0); PG8_STAGE(PG8_SA(0, 1), a2 + hstepA, voffA);
            PG8_WAIT_V(8); PG8_WAIT_L(0); PG8_BAR; PG8_MMA(0, 0, At, B0); PG8_MMA(0, 1, At, B1); PG8_BAR; PG8_SCHED;
            PG8_LDA(At, 1, 1); PG8_STAGE(PG8_SB(1, 0), b3, voffB); PG8_STAGE(PG8_SB(1, 1), b3 + hstepB, voffB); PG8_STAGE(PG8_SA(1, 0), a3, voffA);
            PG8_WAIT_V(8); PG8_WAIT_L(0); PG8_BAR; PG8_MMA(1, 0, At, B0); PG8_MMA(1, 1, At, B1); PG8_BAR; PG8_SCHED;
        }
        if (ALIGN_EPI) { if (wr == 0) PG8_BAR; }
        E(acc, cur, wr, wc, fr, fq);
        if (!has_next) break;
#pragma unroll
        for (int a = 0; a < 2; ++a)
#pragma unroll
            for (int b = 0; b < 2; ++b)
#pragma unroll
                for (int m = 0; m < 4; ++m)
#pragma unroll
                    for (int n = 0; n < 2; ++n) acc[a][b][m][n] = (f32x4){0.f, 0.f, 0.f, 0.f};
        cur = nxt; cA = nA; cB = nB; ++ui;
        if (ALIGN_EPI) { if (wr == 1) PG8_BAR; }
    }
    PG8_WAIT_V(0);
    if (!ALIGN_EPI) { if (wr == 0) PG8_BAR; }
    PG8_BAR;
#undef PG8_SA
#undef PG8_SB
#undef PG8_STAGE
#undef PG8_LDA
#undef PG8_LDB
#undef PG8_MMA
#undef PG8_WAIT_V
#undef PG8_WAIT_L
#undef PG8_BAR
#undef PG8_SCHED
}
}

constexpr size_t al256(size_t x) { return (x + 255) & ~(size_t)255; }
constexpr size_t SZ_W1T = (size_t)2 * DFF * DM * 2, SZ_WD = (size_t)DM * DFF * 2, SZ_WIN = (size_t)INWP * DM * 2, SZ_WOUT = (size_t)DM * DM * 2;
constexpr size_t SZ_W2T = (size_t)(2 * DFF + DM) * DM * 2, SZ_WUQ = (size_t)768 * 512 * 2, SZ_WUKV = (size_t)1024 * 256 * 2, SZ_WGLU = (size_t)512 * 512 * 2, SZ_WPP = (size_t)DM * PLE * 2;
constexpr size_t WL_W1T = 0, WL_W1D = WL_W1T + SZ_W1T, WL_WIN = WL_W1D + SZ_WD, WL_WOUT = WL_WIN + SZ_WIN, WL_W2T = WL_WOUT + SZ_WOUT, WL_W2D = WL_W2T + SZ_W2T,
                 WL_WUQ = WL_W2D + SZ_WD, WL_WUKV = WL_WUQ + SZ_WUQ, WL_WGLU = WL_WUKV + SZ_WUKV, WL_WPP = WL_WGLU + SZ_WGLU, WL_SIZE = al256(WL_WPP + SZ_WPP);
constexpr size_t WS_CTL = 0, CTL_BYTES = 65536;
constexpr size_t WS_W = 65536;
constexpr size_t WS_XB = al256(WS_W + 2 * WL_SIZE);
constexpr size_t WS_U = al256(WS_XB + (size_t)T * DM * 2);
constexpr size_t WS_PROJ = WS_U, WS_QM = al256(WS_PROJ + (size_t)T * INWP * 2), WS_KVM = al256(WS_QM + (size_t)T * 768 * 2), WS_UEND = al256(WS_KVM + (size_t)T * 1024 * 2);
constexpr size_t WS_ACT = WS_U;
static_assert(WS_ACT + (size_t)T * DFF * 2 <= WS_UEND, "ACT overlays PROJ|QM|KVM");
constexpr size_t WS_MIX = WS_UEND;
constexpr size_t WS_PP = al256(WS_MIX + (size_t)T * DM * 2);
constexpr size_t WS_PB = al256(WS_PP + (size_t)T * DM * 2);
constexpr size_t WS_S5E = al256(WS_PB + (size_t)2 * T * PLE * 2);
constexpr size_t WS_RSTD = al256(WS_S5E + (size_t)BATCH * 64 * 32 * 64 * 2 * 4);
constexpr size_t WS_ROPE = al256(WS_RSTD + (size_t)T * 2 * 4);
constexpr size_t S5T_BYTES = 1024 + 8192 + 8192;
constexpr size_t WS_S5T = al256(WS_ROPE + (size_t)T * 64 * 4);
constexpr size_t WS_S5H = al256(WS_S5T + (size_t)DEPTH * 32 * S5T_BYTES);
constexpr size_t WS_XL = al256(WS_S5H + (size_t)BATCH * 64 * 32 * 64 * 2 * 4);
constexpr size_t WS_END = al256(WS_XL + (size_t)T * DM * 2);

constexpr int LDS_BYTES = 147456;
constexpr int NPH = 1 + 12 * DEPTH;

struct Args {
    const float* in[40]; float* out; unsigned char* ws; int ph_lo, ph_hi;
};
typedef const __attribute__((address_space(4))) Args* ArgsP;
__device__ __forceinline__ ArgsP launder(ArgsP p) { asm volatile("" : "+s"(p)); return p; }

__device__ __forceinline__ void sincos_d(double x, double& s, double& c) {
    const double k = rint(x * 0.15915494309189535);
    double r = fma(-k, 6.283185307179586, x); r = fma(-k, 2.4492935982947064e-16, r);
    const double y = r * 0.125, y2 = y * y;
    double sn = y * (1.0 + y2 * (-1.0 / 6 + y2 * (1.0 / 120 + y2 * (-1.0 / 5040 + y2 * (1.0 / 362880 + y2 * (-1.0 / 39916800 + y2 * (1.0 / 6227020800.0)))))));
    double cs = 1.0 + y2 * (-0.5 + y2 * (1.0 / 24 + y2 * (-1.0 / 720 + y2 * (1.0 / 40320 + y2 * (-1.0 / 3628800 + y2 * (1.0 / 479001600 + y2 * (-1.0 / 87178291200.0)))))));
#pragma unroll
    for (int i = 0; i < 3; ++i) { const double s2 = 2.0 * sn * cs, c2 = 1.0 - 2.0 * sn * sn; sn = s2; cs = c2; }
    s = sn; c = cs;
}
__device__ __forceinline__ double exp_d(double x) {
    const double k = rint(x * 1.4426950408889634);
    const double r = fma(-k, 0.6931471805599453, x) - k * 2.3190468138462996e-17;
    double p = 1.0 / 6227020800.0;
    p = p * r + 1.0 / 479001600; p = p * r + 1.0 / 39916800; p = p * r + 1.0 / 3628800; p = p * r + 1.0 / 362880; p = p * r + 1.0 / 40320; p = p * r + 1.0 / 5040;
    p = p * r + 1.0 / 720; p = p * r + 1.0 / 120; p = p * r + 1.0 / 24; p = p * r + 1.0 / 6; p = p * r + 0.5; p = p * r + 1.0; p = p * r + 1.0;
    const long long e = (long long)k + 1023; const double sc = __longlong_as_double(e << 52);
    return p * sc;
}

__device__ __forceinline__ void transpose_item(const float* __restrict__ W, int K, int N, bf16_t* WT, int ldk, int mode, int row_off, const float* ksc, float* scr, int item, int lane) {
    const int nblk = N / 32, kb = item / nblk, nb = item % nblk, k0 = 64 * kb, n0 = 32 * nb;
    const int drow = (mode == 0) ? (row_off + n0) : (256 * (n0 >> 7) + (n0 & 127) + row_off);
#pragma unroll
    for (int i = 0; i < 8; ++i) { const int kk = 8 * i + (lane >> 3), n4 = 4 * (lane & 7); f32x4 v = *(const f32x4*)(W + (size_t)(k0 + kk) * N + n0 + n4); if (ksc) v = v * ksc[k0 + kk];
        float* d = scr + kk * 33 + n4; d[0] = v[0]; d[1] = v[1]; d[2] = v[2]; d[3] = v[3]; }
    __builtin_amdgcn_wave_barrier(); asm volatile("s_waitcnt lgkmcnt(0)" ::: "memory");
    const int c = lane & 7;
#pragma unroll
    for (int j = 0; j < 4; ++j) { const int n = (lane >> 3) + 8 * j; const float* s = scr + (8 * c) * 33 + n;
        u32x4 o; o.x = cvt_pk(s[0 * 33], s[1 * 33]); o.y = cvt_pk(s[2 * 33], s[3 * 33]); o.z = cvt_pk(s[4 * 33], s[5 * 33]); o.w = cvt_pk(s[6 * 33], s[7 * 33]);
        *(u32x4*)(WT + (size_t)(drow + n) * ldk + k0 + 8 * c) = o; }
    __builtin_amdgcn_wave_barrier(); asm volatile("s_waitcnt lgkmcnt(0)" ::: "memory");
}

__device__ __forceinline__ void s5_table(ArgsP A, int l, int g, int lane, float* Hs);
__device__ __forceinline__ void p0_prologue(ArgsP A, unsigned char* lds, int gw, int ngw, int lane, int wave) {
    float* scr = (float*)(lds + wave * 16384);
    unsigned char* ws = A->ws;
    constexpr int I_FF = 32 * 176, I_IN = 32 * 134, I_SQ = 32 * 64, I_UQ = 8 * 24, I_UKV = 2 * 32, I_GLU = 8 * 16, I_PP = 4 * 64;
    constexpr int PER_L = 6 * I_FF + I_IN + 2 * I_SQ + I_UQ + I_UKV + I_GLU + I_PP;
    for (int it = gw; it < DEPTH * PER_L; it += ngw) {
        const int l = it / PER_L; int r = it % PER_L; unsigned char* wl = ws + WS_W + (size_t)l * WL_SIZE;
        if (r < I_FF) { transpose_item(A->in[4] + (size_t)l * DM * DFF, DM, DFF, (bf16_t*)(wl + WL_W1T), DM, 1, 0, nullptr, scr, r, lane); continue; } r -= I_FF;
        if (r < I_FF) { transpose_item(A->in[5] + (size_t)l * DM * DFF, DM, DFF, (bf16_t*)(wl + WL_W1T), DM, 1, 128, nullptr, scr, r, lane); continue; } r -= I_FF;
        if (r < I_FF) { transpose_item(A->in[6] + (size_t)l * DFF * DM, DFF, DM, (bf16_t*)(wl + WL_W1D), DFF, 0, 0, nullptr, scr, r, lane); continue; } r -= I_FF;
        if (r < I_IN) { transpose_item(A->in[9] + (size_t)l * DM * INW, DM, INW, (bf16_t*)(wl + WL_WIN), DM, 0, 0, nullptr, scr, r, lane); continue; } r -= I_IN;
        if (r < I_SQ) { transpose_item(A->in[10] + (size_t)l * DM * DM, DM, DM, (bf16_t*)(wl + WL_WOUT), DM, 0, 0, nullptr, scr, r, lane); continue; } r -= I_SQ;
        if (r < I_FF) { transpose_item(A->in[32] + (size_t)l * DM * DFF, DM, DFF, (bf16_t*)(wl + WL_W2T), DM, 1, 0, nullptr, scr, r, lane); continue; } r -= I_FF;
        if (r < I_FF) { transpose_item(A->in[33] + (size_t)l * DM * DFF, DM, DFF, (bf16_t*)(wl + WL_W2T), DM, 1, 128, nullptr, scr, r, lane); continue; } r -= I_FF;
        if (r < I_SQ) { transpose_item(A->in[35] + (size_t)l * DM * DM, DM, DM, (bf16_t*)(wl + WL_W2T), DM, 0, 2 * DFF, nullptr, scr, r, lane); continue; } r -= I_SQ;
        if (r < I_FF) { transpose_item(A->in[34] + (size_t)l * DFF * DM, DFF, DM, (bf16_t*)(wl + WL_W2D), DFF, 0, 0, nullptr, scr, r, lane); continue; } r -= I_FF;
        if (r < I_UQ) { transpose_item(A->in[24] + (size_t)l * 512 * 768, 512, 768, (bf16_t*)(wl + WL_WUQ), 512, 0, 0, A->in[23] + l * 512, scr, r, lane); continue; } r -= I_UQ;
        if (r < I_UKV) { transpose_item(A->in[26] + (size_t)l * 128 * 1024, 128, 1024, (bf16_t*)(wl + WL_WUKV), 256, 0, 0, A->in[25] + l * 128, scr, r, lane); continue; } r -= I_UKV;
        if (r < I_GLU) { transpose_item(A->in[21] + (size_t)l * 512 * 512, 512, 512, (bf16_t*)(wl + WL_WGLU), 512, 0, 0, nullptr, scr, r, lane); continue; } r -= I_GLU;
        transpose_item(A->in[37] + (size_t)l * PLE * DM, PLE, DM, (bf16_t*)(wl + WL_WPP), PLE, 0, 0, nullptr, scr, r, lane);
    }
    for (int it = ngw - 1 - gw; it < DEPTH * 32; it += ngw) s5_table(A, it >> 5, it & 31, lane, scr);
    const int gt = gw * 64 + lane, ngt = ngw * 64;
    for (int l = 0; l < DEPTH; ++l) {
        unsigned char* wl = ws + WS_W + (size_t)l * WL_SIZE;
        u32x4* z = (u32x4*)(wl + WL_WIN + (size_t)INW * DM * 2);
        for (int i = gt; i < 64 * DM * 2 / 16; i += ngt) z[i] = (u32x4){0u, 0u, 0u, 0u};
        for (int i = gt; i < 1024 * 16; i += ngt) { const int row = i >> 4, ch = i & 15; *(u32x4*)(wl + WL_WUKV + (size_t)row * 512 + 256 + ch * 16) = (u32x4){0u, 0u, 0u, 0u}; }
    }
    const float* x = A->in[0]; bf16_t* XB = (bf16_t*)(ws + WS_XB);
    for (int m = gw; m < T; m += ngw) {
        const float* xr = x + (size_t)m * DM + 8 * lane; bf16_t* ob = XB + (size_t)m * DM + 8 * lane;
#pragma unroll
        for (int j = 0; j < 4; ++j) { const f32x4 a = *(const f32x4*)(xr + 512 * j), c = *(const f32x4*)(xr + 512 * j + 4);
            u32x4 w; w.x = cvt_pk(a[0], a[1]); w.y = cvt_pk(a[2], a[3]); w.z = cvt_pk(c[0], c[1]); w.w = cvt_pk(c[2], c[3]); *(u32x4*)(ob + 512 * j) = w; }
    }
    { const f32x4* p4 = (const f32x4*)A->in[1]; u32x4* pb = (u32x4*)(ws + WS_PB);
      for (int i = gt; i < DEPTH * T * PLE / 8; i += ngt) { const f32x4 a = p4[2 * i], c = p4[2 * i + 1]; u32x4 w; w.x = cvt_pk(a[0], a[1]); w.y = cvt_pk(a[2], a[3]); w.z = cvt_pk(c[0], c[1]); w.w = cvt_pk(c[2], c[3]); pb[i] = w; } }
    { const int* pos = (const int*)A->in[2]; float* rp = (float*)(ws + WS_ROPE);
      for (int i = gt; i < T * 32; i += ngt) { const int row = i >> 5, j = i & 31; const double inv = exp_d(-(double)j * (9.210340371976184 / 32.0));
          double s, c; sincos_d((double)pos[row] * inv, s, c); rp[2 * i] = (float)c; rp[2 * i + 1] = (float)s; } }
}

__device__ __forceinline__ void ln_phase(const float* gam, const float* bet, const float* XIN, float* XFOUT, bf16_t* XB, bf16_t* XL, const bf16_t* HB, const bf16_t* GP, int gw, int ngw, int lane) {
    f32x4 gq[8], bq[8];
#pragma unroll
    for (int j = 0; j < 4; ++j) { const int col = 8 * lane + 512 * j; gq[2 * j] = *(const f32x4*)(gam + col); gq[2 * j + 1] = *(const f32x4*)(gam + col + 4); bq[2 * j] = *(const f32x4*)(bet + col); bq[2 * j + 1] = *(const f32x4*)(bet + col + 4); }
#pragma unroll
    for (int j = 0; j < 8; ++j) asm volatile("" : "+v"(gq[j]), "+v"(bq[j]));
    for (int m0 = gw; m0 < T; m0 += 2 * ngw) {
        const int m1 = (m0 + ngw < T) ? m0 + ngw : m0;
        f32x4 v[2][8]; float s[2] = {0.f, 0.f};
#pragma unroll
        for (int r = 0; r < 2; ++r) { const int m = r ? m1 : m0; const size_t ro = (size_t)m * DM + 8 * lane;
#pragma unroll
            for (int j = 0; j < 4; ++j) { f32x4 a, c;
                if (XIN) { a = *(const f32x4*)(XIN + ro + 512 * j); c = *(const f32x4*)(XIN + ro + 512 * j + 4); }
                else { const u32x4 xh = *(const u32x4*)(XB + ro + 512 * j); const u32x2 xl = *(const u32x2*)((const unsigned char*)XL + ro + 512 * j);
                    const f32x2_t l0 = __builtin_amdgcn_cvt_pk_f32_fp8((int)xl.x, false), l1 = __builtin_amdgcn_cvt_pk_f32_fp8((int)xl.x, true), l2 = __builtin_amdgcn_cvt_pk_f32_fp8((int)xl.y, false), l3 = __builtin_amdgcn_cvt_pk_f32_fp8((int)xl.y, true);
                    const float ls = 1.f / 512.f;
                    a = (f32x4){bflo(xh.x) + l0.x * ls, bfhi(xh.x) + l0.y * ls, bflo(xh.y) + l1.x * ls, bfhi(xh.y) + l1.y * ls};
                    c = (f32x4){bflo(xh.z) + l2.x * ls, bfhi(xh.z) + l2.y * ls, bflo(xh.w) + l3.x * ls, bfhi(xh.w) + l3.y * ls}; }
                const u32x4 h = *(const u32x4*)(HB + ro + 512 * j);
                a[0] = ALPHA * a[0] + bflo(h.x); a[1] = ALPHA * a[1] + bfhi(h.x); a[2] = ALPHA * a[2] + bflo(h.y); a[3] = ALPHA * a[3] + bfhi(h.y);
                c[0] = ALPHA * c[0] + bflo(h.z); c[1] = ALPHA * c[1] + bfhi(h.z); c[2] = ALPHA * c[2] + bflo(h.w); c[3] = ALPHA * c[3] + bfhi(h.w);
                if (GP) { const u32x4 q = *(const u32x4*)(GP + ro + 512 * j); a[0] += bflo(q.x); a[1] += bfhi(q.x); a[2] += bflo(q.y); a[3] += bfhi(q.y); c[0] += bflo(q.z); c[1] += bfhi(q.z); c[2] += bflo(q.w); c[3] += bfhi(q.w); }
                v[r][2 * j] = a; v[r][2 * j + 1] = c; s[r] += ((a[0] + a[1]) + (a[2] + a[3])) + ((c[0] + c[1]) + (c[2] + c[3])); } }
        float mean[2], s2[2] = {0.f, 0.f}, rstd[2];
#pragma unroll
        for (int r = 0; r < 2; ++r) mean[r] = wave_sum(s[r]) * (1.f / DM);
#pragma unroll
        for (int r = 0; r < 2; ++r)
#pragma unroll
            for (int j = 0; j < 8; ++j) { v[r][j] = v[r][j] - mean[r]; s2[r] += (v[r][j][0] * v[r][j][0] + v[r][j][1] * v[r][j][1]) + (v[r][j][2] * v[r][j][2] + v[r][j][3] * v[r][j][3]); }
#pragma unroll
        for (int r = 0; r < 2; ++r) rstd[r] = 1.f / sqrtf(wave_sum(s2[r]) * (1.f / DM) + 1e-5f);
#pragma unroll
        for (int r = 0; r < 2; ++r) { const int m = r ? m1 : m0; const size_t ro = (size_t)m * DM + 8 * lane;
#pragma unroll
            for (int j = 0; j < 4; ++j) {
                const f32x4 oa = v[r][2 * j] * rstd[r] * gq[2 * j] + bq[2 * j], oc = v[r][2 * j + 1] * rstd[r] * gq[2 * j + 1] + bq[2 * j + 1];
                u32x4 w; w.x = cvt_pk(oa[0], oa[1]); w.y = cvt_pk(oa[2], oa[3]); w.z = cvt_pk(oc[0], oc[1]); w.w = cvt_pk(oc[2], oc[3]); if (!XFOUT) *(u32x4*)(XB + ro + 512 * j) = w;
                int w0 = __builtin_amdgcn_cvt_pk_fp8_f32((oa[0] - bflo(w.x)) * 512.f, (oa[1] - bfhi(w.x)) * 512.f, 0, false); w0 = __builtin_amdgcn_cvt_pk_fp8_f32((oa[2] - bflo(w.y)) * 512.f, (oa[3] - bfhi(w.y)) * 512.f, w0, true);
                int w1 = __builtin_amdgcn_cvt_pk_fp8_f32((oc[0] - bflo(w.z)) * 512.f, (oc[1] - bfhi(w.z)) * 512.f, 0, false); w1 = __builtin_amdgcn_cvt_pk_fp8_f32((oc[2] - bflo(w.w)) * 512.f, (oc[3] - bfhi(w.w)) * 512.f, w1, true);
                if (!XFOUT) *(u32x2*)((unsigned char*)XL + ro + 512 * j) = (u32x2){(unsigned)w0, (unsigned)w1};
                if (XFOUT) { *(f32x4*)(XFOUT + ro + 512 * j) = oa; *(f32x4*)(XFOUT + ro + 512 * j + 4) = oc; } } }
    }
}

struct S5Coef { float ar, ai, aLr, aLi; float bbr[16], bbi[16]; };
__device__ __forceinline__ void s5_setup(ArgsP A, int l, int g, int p, S5Coef& C) {
    const int gi = (l * 32 + g) * 64 + p;
    const double lr = (double)A->in[13][gi], li = (double)A->in[14][gi], dt = exp_d((double)A->in[15][l * 32 + g]);
    const double mag = exp_d(lr * dt); double sn, cs; sincos_d(li * dt, sn, cs);
    const double ar = mag * cs, ai = mag * sn, den = lr * lr + li * li, am1 = ar - 1.0;
    const double fr = (am1 * lr + ai * li) / den, fi = (ai * lr - am1 * li) / den;
    const f32x4* br = (const f32x4*)(A->in[16] + (size_t)gi * 16); const f32x4* bi = (const f32x4*)(A->in[17] + (size_t)gi * 16);
#pragma unroll
    for (int q = 0; q < 4; ++q) { const f32x4 r4 = br[q], i4 = bi[q];
#pragma unroll
        for (int e = 0; e < 4; ++e) { C.bbr[q * 4 + e] = (float)(fr * r4[e] - fi * i4[e]); C.bbi[q * 4 + e] = (float)(fr * i4[e] + fi * r4[e]); } }
    double pr = ar, pi = ai;
#pragma unroll
    for (int i = 0; i < 6; ++i) { const double nr = pr * pr - pi * pi, ni = 2.0 * pr * pi; pr = nr; pi = ni; }
    C.ar = (float)ar; C.ai = (float)ai; C.aLr = (float)pr; C.aLi = (float)pi;
}
#define S5_LDS_FENCE() do { __builtin_amdgcn_wave_barrier(); asm volatile("s_waitcnt lgkmcnt(0)" ::: "memory"); } while (0)
__device__ __forceinline__ void s5_bmat(const S5Coef& C, float* Hs, int lane, bf16x8 (&bm)[8]) {
#pragma unroll
    for (int q = 0; q < 4; ++q) { *(f32x4*)(Hs + lane * 16 + 4 * q) = (f32x4){C.bbr[4 * q], C.bbr[4 * q + 1], C.bbr[4 * q + 2], C.bbr[4 * q + 3]};
                                  *(f32x4*)(Hs + (64 + lane) * 16 + 4 * q) = (f32x4){C.bbi[4 * q], C.bbi[4 * q + 1], C.bbi[4 * q + 2], C.bbi[4 * q + 3]}; }
    S5_LDS_FENCE();
    const int kq = lane >> 4;
#pragma unroll
    for (int nb = 0; nb < 8; ++nb) { const float* src = Hs + (16 * nb + (lane & 15)) * 16 + 8 * (kq & 1); const f32x4 v0 = *(const f32x4*)src, v1 = *(const f32x4*)(src + 4);
        float v[8] = {v0[0], v0[1], v0[2], v0[3], v1[0], v1[1], v1[2], v1[3]};
        if (kq >= 2) {
#pragma unroll
            for (int e = 0; e < 8; ++e) v[e] = v[e] - bf2f(f2bf(v[e])); }
        u32x4 w; w.x = cvt_pk(v[0], v[1]); w.y = cvt_pk(v[2], v[3]); w.z = cvt_pk(v[4], v[5]); w.w = cvt_pk(v[6], v[7]); bm[nb] = __builtin_bit_cast(bf16x8, w); }
    S5_LDS_FENCE();
}
__device__ __forceinline__ void s5_table(ArgsP A, int l, int g, int lane, float* Hs) {
    unsigned char* tb = A->ws + WS_S5T + (size_t)(l * 32 + g) * S5T_BYTES;
    S5Coef C; s5_setup(A, l, g, lane, C);
    bf16x8 bm[8]; s5_bmat(C, Hs, lane, bm);
    ((f32x4*)tb)[lane] = (f32x4){C.ar, C.ai, C.aLr, C.aLi};
#pragma unroll
    for (int nb = 0; nb < 8; ++nb) ((bf16x8*)(tb + 1024))[nb * 64 + lane] = bm[nb];
    const float* cre = A->in[18] + (size_t)((l * 32 + g) * 16 + (lane & 15)) * 64; const float* cim = A->in[19] + (size_t)((l * 32 + g) * 16 + (lane & 15)) * 64;
#pragma unroll
    for (int ks = 0; ks < 4; ++ks) { const float* src = (ks < 2 ? cre : cim) + 32 * (ks & 1) + 8 * (lane >> 4); const float sg = ks < 2 ? 1.f : -1.f;
        const f32x4 v0 = *(const f32x4*)src * sg, v1 = *(const f32x4*)(src + 4) * sg;
        u32x4 wh; wh.x = cvt_pk(v0[0], v0[1]); wh.y = cvt_pk(v0[2], v0[3]); wh.z = cvt_pk(v1[0], v1[1]); wh.w = cvt_pk(v1[2], v1[3]);
        u32x4 wl; wl.x = cvt_pk(v0[0] - bflo(wh.x), v0[1] - bfhi(wh.x)); wl.y = cvt_pk(v0[2] - bflo(wh.y), v0[3] - bfhi(wh.y)); wl.z = cvt_pk(v1[0] - bflo(wh.z), v1[1] - bfhi(wh.z)); wl.w = cvt_pk(v1[2] - bflo(wh.w), v1[3] - bfhi(wh.w));
        ((u32x4*)(tb + 9216))[(2 * ks) * 64 + lane] = wh; ((u32x4*)(tb + 9216))[(2 * ks + 1) * 64 + lane] = wl; }
}
__device__ __forceinline__ void s5_fetch(ArgsP A, int l, int g, int lane, S5Coef& C, bf16x8 (&bm)[8]) {
    const unsigned char* tb = A->ws + WS_S5T + (size_t)(l * 32 + g) * S5T_BYTES;
    const f32x4 c = ((const f32x4*)tb)[lane]; C.ar = c[0]; C.ai = c[1]; C.aLr = c[2]; C.aLi = c[3];
#pragma unroll
    for (int nb = 0; nb < 8; ++nb) bm[nb] = ((const bf16x8*)(tb + 1024))[nb * 64 + lane];
}
__device__ __forceinline__ u32x4 s5_load_ua(const bf16_t* PROJ, int row0, int g, int lane) { return *(const u32x4*)(PROJ + (size_t)(row0 + (lane & 15)) * INWP + C_S5 + 16 * g + 8 * ((lane >> 4) & 1)); }
template <bool WRITEH>
__device__ __forceinline__ void s5_block(const S5Coef& C, const bf16x8 (&bm)[8], u32x4 uw, float* Hs, int lane, float& hr, float& hi) {
    const bf16x8 ua = __builtin_bit_cast(bf16x8, uw);
#pragma unroll
    for (int nb = 0; nb < 8; ++nb) { const f32x4 d = __builtin_amdgcn_mfma_f32_16x16x32_bf16(ua, bm[nb], (f32x4){0.f, 0.f, 0.f, 0.f}, 0, 0, 0);
#pragma unroll
        for (int i = 0; i < 4; ++i) Hs[(4 * (lane >> 4) + i) * 132 + 16 * nb + (lane & 15)] = d[i]; }
    S5_LDS_FENCE();
    float bur[16], bui[16];
#pragma unroll
    for (int tl = 0; tl < 16; ++tl) { bur[tl] = Hs[tl * 132 + lane]; bui[tl] = Hs[tl * 132 + 64 + lane]; }
#pragma unroll
    for (int tl = 0; tl < 16; ++tl) { const float nr = C.ar * hr - C.ai * hi + bur[tl], ni = C.ar * hi + C.ai * hr + bui[tl]; hr = nr; hi = ni; bur[tl] = hr; bui[tl] = hi; }
    if (WRITEH) {
#pragma unroll
        for (int tl = 0; tl < 16; ++tl) { Hs[tl * 132 + lane] = bur[tl]; Hs[tl * 132 + 64 + lane] = bui[tl]; }
    }
    S5_LDS_FENCE();
}
__device__ __forceinline__ void s5_local(ArgsP A, int l, int item, int lane, float* Hs) {
    const int g = item & 31, c = (item >> 5) & 63, b = item >> 11;
    const bf16_t* PROJ = (const bf16_t*)(A->ws + WS_PROJ);
    u32x4 uw[4];
#pragma unroll
    for (int blk = 0; blk < 4; ++blk) uw[blk] = s5_load_ua(PROJ, b * SEQ + 64 * c + 16 * blk, g, lane);
    S5Coef C; bf16x8 bm[8]; s5_fetch(A, l, g, lane, C, bm);
    float hr = 0.f, hi = 0.f;
#pragma unroll
    for (int blk = 0; blk < 4; ++blk) s5_block<false>(C, bm, uw[blk], Hs, lane, hr, hi);
    f32x2_t* E = (f32x2_t*)(A->ws + WS_S5E); E[(size_t)((b * 64 + c) * 32 + g) * 64 + lane] = (f32x2_t){hr, hi};
}
__device__ __forceinline__ void s5_prefix(ArgsP A, int l, int item, int lane) {
    const int b = item >> 5, g = item & 31;
    const f32x4 cf = ((const f32x4*)(A->ws + WS_S5T + (size_t)(l * 32 + g) * S5T_BYTES))[lane]; const float aLr = cf[2], aLi = cf[3];
    const f32x2_t* E = (const f32x2_t*)(A->ws + WS_S5E); f32x2_t* H = (f32x2_t*)(A->ws + WS_S5H);
    float hr = 0.f, hi = 0.f;
    for (int c0 = 0; c0 < 64; c0 += 16) {
        f32x2_t e[16];
#pragma unroll
        for (int j = 0; j < 16; ++j) e[j] = E[(size_t)((b * 64 + c0 + j) * 32 + g) * 64 + lane];
#pragma unroll
        for (int j = 0; j < 16; ++j) { H[(size_t)((b * 64 + c0 + j) * 32 + g) * 64 + lane] = (f32x2_t){hr, hi};
            const float nr = aLr * hr - aLi * hi + e[j].x, ni = aLr * hi + aLi * hr + e[j].y; hr = nr; hi = ni; }
    }
}
__device__ __forceinline__ float gelu_tanh(float x) {
    const float z = 0.7978845608028654f * (x + 0.044715f * x * x * x);
    const float e = fast_exp2(2.f * z * LOG2E);
    const float th = 1.f - 2.f * fast_rcp(1.f + e);
    return 0.5f * x * (1.f + th);
}
constexpr int YS_STRIDE = 520;
__device__ __forceinline__ void s5_unit(ArgsP A, int l, int unit, unsigned char* lds, int wave_, int lane_) {
    int tid_ = threadIdx.x; asm volatile("" : "+v"(tid_)); const int lane = tid_ & 63, wave = __builtin_amdgcn_readfirstlane(tid_ >> 6);
    const int b = unit >> 6, c = unit & 63, rowbase = b * SEQ + 64 * c;
    const bf16_t* PROJ = (const bf16_t*)(A->ws + WS_PROJ);
    bf16_t* ys = (bf16_t*)lds;
    float* Hs = (float*)(lds + 66560 + wave * 8448);
    const f32x2_t* E = (const f32x2_t*)(A->ws + WS_S5E);
    for (int gi = 0; gi < 4; ++gi) {
        const int g = 4 * wave + gi;
        S5Coef C; bf16x8 bm[8]; s5_fetch(A, l, g, lane, C, bm);
        bf16x8 chl[8];
        { const bf16x8* ct = (const bf16x8*)(A->ws + WS_S5T + (size_t)(l * 32 + g) * S5T_BYTES + 9216);
#pragma unroll
          for (int q = 0; q < 8; ++q) chl[q] = ct[q * 64 + lane]; }
        const f32x2_t hin = ((const f32x2_t*)(A->ws + WS_S5H))[(size_t)((b * 64 + c) * 32 + g) * 64 + lane]; float hr = hin.x, hi = hin.y;
        u32x4 uw[4];
#pragma unroll
        for (int blk = 0; blk < 4; ++blk) uw[blk] = s5_load_ua(PROJ, rowbase + 16 * blk, g, lane);
        const float dv = A->in[20][l * 512 + 16 * g + (lane & 15)];
#pragma unroll
        for (int blk = 0; blk < 4; ++blk) {
            unsigned short uraw[4];
#pragma unroll
            for (int i = 0; i < 4; ++i) uraw[i] = PROJ[(size_t)(rowbase + 16 * blk + 4 * (lane >> 4) + i) * INWP + C_S5 + 16 * g + (lane & 15)];
            s5_block<true>(C, bm, uw[blk], Hs, lane, hr, hi);
            f32x4 y = (f32x4){0.f, 0.f, 0.f, 0.f}, y2 = (f32x4){0.f, 0.f, 0.f, 0.f};
#pragma unroll
            for (int ks = 0; ks < 4; ++ks) { const float* hp = Hs + (lane & 15) * 132 + 32 * ks + 8 * (lane >> 4); const f32x4 h0 = *(const f32x4*)hp, h1 = *(const f32x4*)(hp + 4);
                u32x4 wh; wh.x = cvt_pk(h0[0], h0[1]); wh.y = cvt_pk(h0[2], h0[3]); wh.z = cvt_pk(h1[0], h1[1]); wh.w = cvt_pk(h1[2], h1[3]);
                u32x4 wl; wl.x = cvt_pk(h0[0] - bflo(wh.x), h0[1] - bfhi(wh.x)); wl.y = cvt_pk(h0[2] - bflo(wh.y), h0[3] - bfhi(wh.y)); wl.z = cvt_pk(h1[0] - bflo(wh.z), h1[1] - bfhi(wh.z)); wl.w = cvt_pk(h1[2] - bflo(wh.w), h1[3] - bfhi(wh.w));
                const bf16x8 hh_ = __builtin_bit_cast(bf16x8, wh), hl_ = __builtin_bit_cast(bf16x8, wl);
                y = __builtin_amdgcn_mfma_f32_16x16x32_bf16(hh_, chl[2 * ks], y, 0, 0, 0); y2 = __builtin_amdgcn_mfma_f32_16x16x32_bf16(hh_, chl[2 * ks + 1], y2, 0, 0, 0);
                y2 = __builtin_amdgcn_mfma_f32_16x16x32_bf16(hl_, chl[2 * ks], y2, 0, 0, 0); }
            y = y + y2;
#pragma unroll
            for (int i = 0; i < 4; ++i) { const int t = 16 * blk + 4 * (lane >> 4) + i; const int col = 16 * g + (lane & 15);
                const float uval = bf2f(uraw[i]); const float v = gelu_tanh(y[i] + dv * uval); ys[t * YS_STRIDE + col] = f2bf(v); }
            __builtin_amdgcn_wave_barrier(); asm volatile("s_waitcnt lgkmcnt(0)" ::: "memory");
        }
    }
    __syncthreads();
    const bf16_t* WG = (const bf16_t*)(A->ws + WS_W + (size_t)l * WL_SIZE + WL_WGLU);
    f32x4 acc[4][4];
#pragma unroll
    for (int mb = 0; mb < 4; ++mb)
#pragma unroll
        for (int nb = 0; nb < 4; ++nb) acc[mb][nb] = (f32x4){0.f, 0.f, 0.f, 0.f};
    {
        const bf16_t* wb = WG + (size_t)(64 * wave + (lane & 15)) * 512 + 8 * (lane >> 4);
        bf16x8 bq[4][4];
#pragma unroll
        for (int p = 0; p < 4; ++p)
#pragma unroll
            for (int nb = 0; nb < 4; ++nb) bq[p][nb] = *(const bf16x8*)(wb + (size_t)(16 * nb) * 512 + 32 * p);
#pragma unroll
        for (int ks = 0; ks < 16; ++ks) {
            bf16x8 af[4];
#pragma unroll
            for (int mb = 0; mb < 4; ++mb) af[mb] = *(const bf16x8*)(ys + (16 * mb + (lane & 15)) * YS_STRIDE + 32 * ks + 8 * (lane >> 4));
            asm volatile("" : "+v"(bq[ks & 3][0]), "+v"(bq[ks & 3][1]), "+v"(bq[ks & 3][2]), "+v"(bq[ks & 3][3]) :: "memory");
#pragma unroll
            for (int mb = 0; mb < 4; ++mb)
#pragma unroll
                for (int nb = 0; nb < 4; ++nb) acc[mb][nb] = __builtin_amdgcn_mfma_f32_16x16x32_bf16(af[mb], bq[ks & 3][nb], acc[mb][nb], 0, 0, 0);
            if (ks + 4 < 16) {
#pragma unroll
                for (int nb = 0; nb < 4; ++nb) bq[ks & 3][nb] = *(const bf16x8*)(wb + (size_t)(16 * nb) * 512 + 32 * (ks + 4));
            }
        }
    }
    bf16_t* MIX = (bf16_t*)(A->ws + WS_MIX);
    float bglv[4];
#pragma unroll
    for (int nb = 0; nb < 4; ++nb) bglv[nb] = A->in[22][l * 512 + 64 * wave + 16 * nb + (lane & 15)];
#pragma unroll
    for (int nb = 0; nb < 4; ++nb) { const int n = 64 * wave + 16 * nb + (lane & 15); const float bgl = bglv[nb];
#pragma unroll
        for (int mb = 0; mb < 4; ++mb)
#pragma unroll
            for (int i = 0; i < 4; ++i) { const int t = 16 * mb + 4 * (lane >> 4) + i; const float yv = bf2f(ys[t * YS_STRIDE + n]);
                MIX[(size_t)(rowbase + t) * DM + n] = f2bf(yv * sigmoidf_(acc[mb][nb][i] + bgl)); } }
    __syncthreads();
}

struct PrepRegs { u32x4 q; unsigned kv; u32x4 xa, xb; f32x4 t0, t1, t2, t3; };
__device__ __forceinline__ void prep_load(ArgsP A, int row, int lane, PrepRegs& R) {
    const bf16_t* pr = (const bf16_t*)(A->ws + WS_PROJ) + (size_t)row * INWP; const float* rope = (const float*)(A->ws + WS_ROPE) + (size_t)row * 64;
    R.q = *(const u32x4*)(pr + C_CQ + 8 * lane); R.kv = *(const unsigned*)(pr + C_CKV + 2 * lane);
    const int ln = lane < 36 ? lane : 0; const int blk = ln >> 2, j0 = 8 * (ln & 3);
    const int base = (blk == 0) ? C_KR : (blk <= 4 ? C_RQ + 64 * (blk - 1) : C_RK + 64 * (blk - 5));
    R.xa = *(const u32x4*)(pr + base + j0); R.xb = *(const u32x4*)(pr + base + 32 + j0);
    const f32x4* cs = (const f32x4*)(rope + 2 * j0); R.t0 = cs[0]; R.t1 = cs[1]; R.t2 = cs[2]; R.t3 = cs[3];
}
__device__ __forceinline__ void prep_finish(ArgsP A, int row, int lane, const PrepRegs& R) {
    bf16_t* pr = (bf16_t*)(A->ws + WS_PROJ) + (size_t)row * INWP;
    { const u32x4 q = R.q; float s = 0.f;
      s += bflo(q.x) * bflo(q.x) + bfhi(q.x) * bfhi(q.x) + bflo(q.y) * bflo(q.y) + bfhi(q.y) * bfhi(q.y) + bflo(q.z) * bflo(q.z) + bfhi(q.z) * bfhi(q.z) + bflo(q.w) * bflo(q.w) + bfhi(q.w) * bfhi(q.w);
      const unsigned kv = R.kv; float s2 = bflo(kv) * bflo(kv) + bfhi(kv) * bfhi(kv);
      s = wave_sum(s); s2 = wave_sum(s2);
      if (lane == 0) { float* rs = (float*)(A->ws + WS_RSTD) + (size_t)row * 2; rs[0] = 1.f / sqrtf(s * (1.f / 512) + 1e-6f); rs[1] = 1.f / sqrtf(s2 * (1.f / 128) + 1e-6f); } }
    if (lane < 36) {
        const int blk = lane >> 2, j0 = 8 * (lane & 3);
        const int base = (blk == 0) ? C_KR : (blk <= 4 ? C_RQ + 64 * (blk - 1) : C_RK + 64 * (blk - 5));
        float sc = 1.f; if (blk >= 5) { const float lgk = log2f(1.f - exp2f(-5.f - (float)(blk - 5))); sc = 0.125f * fast_exp2(-lgk * (float)(row & 63)); }
        const u32x4 xa = R.xa, xb = R.xb; const f32x4 t0 = R.t0, t1 = R.t1, t2 = R.t2, t3 = R.t3;
        const float a[8] = {bflo(xa.x), bfhi(xa.x), bflo(xa.y), bfhi(xa.y), bflo(xa.z), bfhi(xa.z), bflo(xa.w), bfhi(xa.w)};
        const float bq[8] = {bflo(xb.x), bfhi(xb.x), bflo(xb.y), bfhi(xb.y), bflo(xb.z), bfhi(xb.z), bflo(xb.w), bfhi(xb.w)};
        const float cc[8] = {t0[0], t0[2], t1[0], t1[2], t2[0], t2[2], t3[0], t3[2]}, ss[8] = {t0[1], t0[3], t1[1], t1[3], t2[1], t2[3], t3[1], t3[3]};
        float oa[8], ob[8];
#pragma unroll
        for (int e = 0; e < 8; ++e) { oa[e] = (a[e] * cc[e] - bq[e] * ss[e]) * sc; ob[e] = (a[e] * ss[e] + bq[e] * cc[e]) * sc; }
        u32x4 wa, wb; wa.x = cvt_pk(oa[0], oa[1]); wa.y = cvt_pk(oa[2], oa[3]); wa.z = cvt_pk(oa[4], oa[5]); wa.w = cvt_pk(oa[6], oa[7]);
        wb.x = cvt_pk(ob[0], ob[1]); wb.y = cvt_pk(ob[2], ob[3]); wb.z = cvt_pk(ob[4], ob[5]); wb.w = cvt_pk(ob[6], ob[7]);
        *(u32x4*)(pr + base + j0) = wa; *(u32x4*)(pr + base + 32 + j0) = wb;
    }
}

__device__ __forceinline__ s16x4 vtr(lds_cptr p) { return __builtin_bit_cast(s16x4, __builtin_amdgcn_ds_read_tr16_b64_v4i16((LAS s16x4*)p)); }
__device__ __forceinline__ bf16x8 scale8(u32x4 v, float c) {
    u32x4 o; o.x = cvt_pk(bflo(v.x) * c, bfhi(v.x) * c); o.y = cvt_pk(bflo(v.y) * c, bfhi(v.y) * c); o.z = cvt_pk(bflo(v.z) * c, bfhi(v.z) * c); o.w = cvt_pk(bflo(v.w) * c, bfhi(v.w) * c);
    return __builtin_bit_cast(bf16x8, o);
}
__device__ __forceinline__ void glds16(const void* gsrc, unsigned lds_dst) { unsigned keep;
    asm volatile("s_mov_b32 %0, m0\n\ts_mov_b32 m0, %2\n\ts_nop 0\n\tglobal_load_lds_dwordx4 %1, off\n\ts_mov_b32 m0, %0" : "=&s"(keep) : "v"(gsrc), "s"(lds_dst) : "memory"); }
__device__ __forceinline__ void glds4(const void* gsrc, unsigned lds_dst) { unsigned keep;
    asm volatile("s_mov_b32 %0, m0\n\ts_mov_b32 m0, %2\n\ts_nop 0\n\tglobal_load_lds_dword %1, off\n\ts_mov_b32 m0, %0" : "=&s"(keep) : "v"(gsrc), "s"(lds_dst) : "memory"); }
__device__ __forceinline__ int wave_max_i32(int v) {
    int t;
    t = __builtin_amdgcn_update_dpp(v, v, 0x111, 0xf, 0xf, false); v = t > v ? t : v;
    t = __builtin_amdgcn_update_dpp(v, v, 0x112, 0xf, 0xf, false); v = t > v ? t : v;
    t = __builtin_amdgcn_update_dpp(v, v, 0x114, 0xf, 0xf, false); v = t > v ? t : v;
    t = __builtin_amdgcn_update_dpp(v, v, 0x118, 0xf, 0xf, false); v = t > v ? t : v;
    t = __builtin_amdgcn_update_dpp(v, v, 0x142, 0xa, 0xf, false); v = t > v ? t : v;
    t = __builtin_amdgcn_update_dpp(v, v, 0x143, 0xc, 0xf, false); v = t > v ? t : v;
    return __builtin_amdgcn_readlane(v, 63);
}
__device__ __forceinline__ float max_xor32(float v) {
    const unsigned u = __float_as_uint(v); const auto r = __builtin_amdgcn_permlane32_swap(u, u, false, false);
    return fmaxf(__uint_as_float(r[0]), __uint_as_float(r[1]));
}
__device__ __forceinline__ int crow(int i, int hh) { return (i & 3) + 8 * (i >> 2) + 4 * hh; }

template <int MODE> struct FA;
template <> struct FA<0> { static constexpr int DQK = 192, KCH = 24, QROWS = 256; };
template <> struct FA<1> { static constexpr int DQK = 64,  KCH = 16, QROWS = 128; };
template <> struct FA<2> { static constexpr int DQK = 64,  KCH = 8,  QROWS = 256; };

template <int MODE>
__device__ __forceinline__ void flash_unit(ArgsP A, int l, int b, int h, int qb, unsigned char* lds) {
    constexpr int DQK = FA<MODE>::DQK, KCH = FA<MODE>::KCH, QROWS = FA<MODE>::QROWS, NS = DQK / 16;
    constexpr int KBYTES = 64 * KCH * 16, VBYTES = 64 * 256;
    constexpr int NKI = KCH / 8;
    constexpr int NBUF = (MODE == 0) ? 2 : 4;
    constexpr int OPS = NKI + 2 + (MODE == 1 ? 1 : 0);
    constexpr int OFF_EXTRA = NBUF * (KBYTES + VBYTES);
    int tid = threadIdx.x; asm volatile("" : "+v"(tid));
    const int lane = tid & 63, wave = __builtin_amdgcn_readfirstlane(tid >> 6), q32 = lane & 31, hh = lane >> 5;
    const bf16_t* PROJ = (const bf16_t*)(A->ws + WS_PROJ); const bf16_t* QM = (const bf16_t*)(A->ws + WS_QM); const bf16_t* KVM = (const bf16_t*)(A->ws + WS_KVM);
    bf16_t* MIX = (bf16_t*)(A->ws + WS_MIX);
    const int rowbase = b * SEQ;
    const int wq = (MODE == 1) ? (wave & 3) : wave;
    const int map = (MODE == 1) ? (wave >> 2) : 0;
    const int qi = qb * QROWS + 32 * wq + q32;
    const int qrow = rowbase + qi;
    const int ntile = (qb * QROWS + QROWS) / 64;
    const int tlast = (qb * QROWS + 32 * wq + 31) / 64;
    int* kpos = (int*)(lds + OFF_EXTRA);
    float* btab = (float*)(lds + OFF_EXTRA + NBUF * 256);

    bf16x8 qf[NS];
    if (MODE == 0) {
        const float csc = 0.07216878364870322f * LOG2E;
        const bf16_t* qp = QM + (size_t)qrow * 768 + 192 * h + 8 * hh;
        u32x4 raw[NS];
#pragma unroll
        for (int s = 0; s < NS; ++s) raw[s] = *(const u32x4*)(qp + 16 * s);
#pragma unroll
        for (int s = 0; s < 8; ++s) qf[s] = scale8(raw[s], csc);
        const float* rope = (const float*)(A->ws + WS_ROPE) + (size_t)qrow * 64;
#pragma unroll
        for (int pr = 0; pr < 2; ++pr) {
            const u32x4 xa = raw[8 + pr], xb = raw[10 + pr]; const f32x4* cs = (const f32x4*)(rope + 2 * (16 * pr + 8 * hh));
            float a[8], bb[8], oa[8], ob[8];
            a[0] = bflo(xa.x); a[1] = bfhi(xa.x); a[2] = bflo(xa.y); a[3] = bfhi(xa.y); a[4] = bflo(xa.z); a[5] = bfhi(xa.z); a[6] = bflo(xa.w); a[7] = bfhi(xa.w);
            bb[0] = bflo(xb.x); bb[1] = bfhi(xb.x); bb[2] = bflo(xb.y); bb[3] = bfhi(xb.y); bb[4] = bflo(xb.z); bb[5] = bfhi(xb.z); bb[6] = bflo(xb.w); bb[7] = bfhi(xb.w);
#pragma unroll
            for (int jj = 0; jj < 4; ++jj) { const f32x4 t4 = cs[jj];
                oa[2 * jj] = (a[2 * jj] * t4[0] - bb[2 * jj] * t4[1]) * csc; ob[2 * jj] = (a[2 * jj] * t4[1] + bb[2 * jj] * t4[0]) * csc;
                oa[2 * jj + 1] = (a[2 * jj + 1] * t4[2] - bb[2 * jj + 1] * t4[3]) * csc; ob[2 * jj + 1] = (a[2 * jj + 1] * t4[3] + bb[2 * jj + 1] * t4[2]) * csc; }
            u32x4 wa, wb; wa.x = cvt_pk(oa[0], oa[1]); wa.y = cvt_pk(oa[2], oa[3]); wa.z = cvt_pk(oa[4], oa[5]); wa.w = cvt_pk(oa[6], oa[7]);
            wb.x = cvt_pk(ob[0], ob[1]); wb.y = cvt_pk(ob[2], ob[3]); wb.z = cvt_pk(ob[4], ob[5]); wb.w = cvt_pk(ob[6], ob[7]);
            qf[8 + pr] = __builtin_bit_cast(bf16x8, wa); qf[10 + pr] = __builtin_bit_cast(bf16x8, wb);
        }
    } else if (MODE == 1) {
        const float csc = 0.125f * LOG2E;
        const bf16_t* qp = PROJ + (size_t)qrow * INWP + C_DQ + 128 * h + 64 * map + 8 * hh;
#pragma unroll
        for (int s = 0; s < NS; ++s) qf[s] = scale8(*(const u32x4*)(qp + 16 * s), csc);
    } else {
        const bf16_t* qp = PROJ + (size_t)qrow * INWP + C_RQ + 64 * h + 8 * hh;
#pragma unroll
        for (int s = 0; s < NS; ++s) qf[s] = __builtin_bit_cast(bf16x8, *(const u32x4*)(qp + 16 * s));
    }
    int posq = 0, qmin = 0; float bfar = 0.f;
    if (MODE == 1) {
        const int* pos = (const int*)A->in[2];
        if (tid < 129) { int n = tid; int bucket;
            if (n < 16) bucket = n; else { const float nf = (float)n; int lg = 16 + (int)(logf(nf / 16.f) / 2.0794415416798357f * 16.f); bucket = lg < 31 ? lg : 31; }
            if (tid == 128) bucket = 31;
            btab[tid] = A->in[3][bucket * 4 + h] * LOG2E; }
        posq = pos[qrow];
        int mn = posq;
#pragma unroll
        for (int o = 1; o < 64; o <<= 1) { const int other = __shfl_xor(mn, o); mn = other < mn ? other : mn; }
        qmin = mn;
    }
    float lg2 = 0.f;
    if (MODE == 2) lg2 = log2f(1.f - exp2f(-5.f - (float)h));

    const unsigned lds0 = (unsigned)(uintptr_t)lds;
    int kbase[4];
#pragma unroll
    for (int bsel = 0; bsel < 4; ++bsel) { const int ch = 2 * bsel + hh + (MODE == 1 ? 8 * map : 0), xr = (MODE == 1) ? (q32 & 15) : ((q32 >> 1) & 7); kbase[bsel] = (q32 * KCH + (ch ^ xr)) * 16; }
    auto dma_tile = [&](int t) {
        const int kr0 = rowbase + 64 * t;
        const int slot = t % NBUF; const unsigned kb_ = lds0 + slot * KBYTES, vb_ = lds0 + NBUF * KBYTES + slot * VBYTES;
#pragma unroll
        for (int i = 0; i < NKI; ++i) { const int piece = wave + 8 * i, p = 64 * piece + lane, key = p / KCH, cs = p % KCH;
            const int ch = cs ^ (MODE == 1 ? (key & 15) : ((key >> 1) & 7)); const bf16_t* src;
            if (MODE == 0) src = (ch < 16) ? KVM + (size_t)(kr0 + key) * 1024 + 256 * h + 8 * ch : PROJ + (size_t)(kr0 + key) * INWP + C_KR + 8 * (ch - 16);
            else if (MODE == 1) src = PROJ + (size_t)(kr0 + key) * INWP + C_DK + 128 * h + 8 * ch;
            else src = PROJ + (size_t)(kr0 + key) * INWP + C_RK + 64 * h + 8 * ch;
            glds16(src, (unsigned)__builtin_amdgcn_readfirstlane(kb_ + piece * 1024)); }
#pragma unroll
        for (int i = 0; i < 2; ++i) { const int piece = wave + 8 * i, p = 64 * piece + lane, st = p >> 5, key = 8 * (st >> 2) + ((p & 31) >> 2), col = 32 * (st & 3) + 8 * (p & 3); const bf16_t* src;
            if (MODE == 0) src = KVM + (size_t)(kr0 + key) * 1024 + 256 * h + 128 + col;
            else if (MODE == 1) src = PROJ + (size_t)(kr0 + key) * INWP + C_DV + 128 * h + col;
            else src = PROJ + (size_t)(kr0 + key) * INWP + C_RV + 128 * h + col;
            glds16(src, (unsigned)__builtin_amdgcn_readfirstlane(vb_ + piece * 1024)); }
        if (MODE == 1) glds4((const int*)A->in[2] + rowbase + 64 * t + lane, (unsigned)__builtin_amdgcn_readfirstlane(lds0 + OFF_EXTRA + slot * 256));
    };

    f32x16 oacc[4];
#pragma unroll
    for (int c = 0; c < 4; ++c)
#pragma unroll
        for (int i = 0; i < 16; ++i) oacc[c][i] = 0.f;
    float m_run = -INFINITY, l_run = 0.f;

#pragma unroll
    for (int s_ = 0; s_ < NS; ++s_) asm volatile("" : "+v"(qf[s_]));
    asm volatile("" : "+v"(posq), "+v"(qmin), "+v"(lg2));
    __syncthreads();
#pragma unroll
    for (int i = 0; i < NBUF - 1; ++i) if (i < ntile) dma_tile(i);
    for (int t = 0; t < ntile; ++t) {
        {
            const int later = (ntile - 1 - t) < (NBUF - 2) ? (ntile - 1 - t) : (NBUF - 2);
            if (later <= 0) asm volatile("s_waitcnt vmcnt(0) lgkmcnt(0)\n\ts_barrier" ::: "memory");
            else if (later == 1) asm volatile("s_waitcnt vmcnt(%0) lgkmcnt(0)\n\ts_barrier" :: "n"(OPS) : "memory");
            else asm volatile("s_waitcnt vmcnt(%0) lgkmcnt(0)\n\ts_barrier" :: "n"(2 * OPS) : "memory");
        }
        if (t + NBUF - 1 < ntile) dma_tile(t + NBUF - 1);
        if (t <= tlast) {
            const int slot = t % NBUF; const unsigned char* kb_ = lds + slot * KBYTES; const unsigned char* vb_ = lds + NBUF * KBYTES + slot * VBYTES;
            f32x16 sacc[2];
#pragma unroll
            for (int kb = 0; kb < 2; ++kb)
#pragma unroll
                for (int i = 0; i < 16; ++i) sacc[kb][i] = 0.f;
            {
                const unsigned char* kbuf = kb_;
                auto kld = [&](int f) { const int s_ = f >> 1, kbb = f & 1; const int bsel = (MODE == 0) ? (s_ & 3) : s_, imm = ((MODE == 0) ? (s_ >> 2) * 128 : 0) + kbb * (32 * KCH * 16);
                    return *(const bf16x8*)(kbuf + kbase[bsel] + imm); };
                constexpr int NB = (2 * NS) / 4;
                bf16x8 ka0 = kld(0), ka1 = kld(1), ka2 = kld(2), ka3 = kld(3), kb0, kb1, kb2, kb3;
#pragma unroll
                for (int bt = 0; bt < NB; bt += 2) {
                    if (bt + 1 < NB) { kb0 = kld(4 * bt + 4); kb1 = kld(4 * bt + 5); kb2 = kld(4 * bt + 6); kb3 = kld(4 * bt + 7); }
                    asm volatile("" : "+v"(ka0), "+v"(ka1), "+v"(ka2), "+v"(ka3) :: "memory");
                    sacc[0] = __builtin_amdgcn_mfma_f32_32x32x16_bf16(ka0, qf[2 * bt], sacc[0], 0, 0, 0); sacc[1] = __builtin_amdgcn_mfma_f32_32x32x16_bf16(ka1, qf[2 * bt], sacc[1], 0, 0, 0);
                    sacc[0] = __builtin_amdgcn_mfma_f32_32x32x16_bf16(ka2, qf[2 * bt + 1], sacc[0], 0, 0, 0); sacc[1] = __builtin_amdgcn_mfma_f32_32x32x16_bf16(ka3, qf[2 * bt + 1], sacc[1], 0, 0, 0);
                    if (bt + 1 < NB) {
                        if (bt + 2 < NB) { ka0 = kld(4 * bt + 8); ka1 = kld(4 * bt + 9); ka2 = kld(4 * bt + 10); ka3 = kld(4 * bt + 11); }
                        asm volatile("" : "+v"(kb0), "+v"(kb1), "+v"(kb2), "+v"(kb3) :: "memory");
                        sacc[0] = __builtin_amdgcn_mfma_f32_32x32x16_bf16(kb0, qf[2 * bt + 2], sacc[0], 0, 0, 0); sacc[1] = __builtin_amdgcn_mfma_f32_32x32x16_bf16(kb1, qf[2 * bt + 2], sacc[1], 0, 0, 0);
                        sacc[0] = __builtin_amdgcn_mfma_f32_32x32x16_bf16(kb2, qf[2 * bt + 3], sacc[0], 0, 0, 0); sacc[1] = __builtin_amdgcn_mfma_f32_32x32x16_bf16(kb3, qf[2 * bt + 3], sacc[1], 0, 0, 0);
                    }
                }
            }
            const bool diag = (t == tlast);
            if (MODE == 2) {
                const float gq = fast_exp2(lg2 * (float)(qi - 64 * t));
                if (diag) {
                    asm volatile("" ::: "memory");
#pragma unroll
                    for (int kb = 0; kb < 2; ++kb)
#pragma unroll
                        for (int i = 0; i < 16; ++i) sacc[kb][i] = (64 * t + 32 * kb + crow(i, hh) > qi) ? 0.f : sacc[kb][i] * gq;
                } else {
#pragma unroll
                    for (int kb = 0; kb < 2; ++kb)
#pragma unroll
                        for (int i = 0; i < 16; ++i) sacc[kb][i] *= gq;
                }
            } else {
                float boff = 0.f;
                if (MODE == 1) {
                    const int* kp = kpos + slot * 64;
                    const int kmx = wave_max_i32(kp[lane]);
                    if (qmin - kmx >= 128) { boff = btab[128];
                    } else {
#pragma unroll
                        for (int kb = 0; kb < 2; ++kb)
#pragma unroll
                            for (int i = 0; i < 16; ++i) { int d = posq - kp[32 * kb + crow(i, hh)]; d = d < 0 ? 0 : (d > 128 ? 128 : d); sacc[kb][i] += btab[d]; }
                    }
                }
                if (diag) {
                    asm volatile("" ::: "memory");
#pragma unroll
                    for (int kb = 0; kb < 2; ++kb)
#pragma unroll
                        for (int i = 0; i < 16; ++i) if (64 * t + 32 * kb + crow(i, hh) > qi) sacc[kb][i] = -INFINITY;
                }
                float mx = sacc[0][0];
#pragma unroll
                for (int kb = 0; kb < 2; ++kb)
#pragma unroll
                    for (int i = 0; i < 16; ++i) mx = fmaxf(mx, sacc[kb][i]);
                mx = max_xor32(mx) + boff;
                if (__builtin_amdgcn_ballot_w64(mx > m_run + 6.0f) != 0ull) {
                    const float mnew = fmaxf(m_run, mx), alpha = fast_exp2(m_run - mnew);
                    m_run = mnew; l_run *= alpha;
#pragma unroll
                    for (int c = 0; c < 4; ++c)
#pragma unroll
                        for (int i = 0; i < 16; ++i) oacc[c][i] *= alpha;
                }
                const float msub = m_run - boff; float rs = 0.f;
#pragma unroll
                for (int kb = 0; kb < 2; ++kb)
#pragma unroll
                    for (int i = 0; i < 16; ++i) { const float p = fast_exp2(sacc[kb][i] - msub); sacc[kb][i] = p; rs += p; }
                l_run += rs;
            }
            {
                const lds_cptr vlane = (lds_cptr)vb_ + (4 * hh + ((lane & 15) >> 2)) * 64 + 32 * ((lane >> 4) & 1) + 8 * (lane & 3);
                auto vfrag = [&](int sp, int c) { const lds_cptr vbase = vlane + (4 * (sp >> 1) + 2 * (sp & 1)) * 2048 + c * 512;
                    const s16x4 v0 = vtr(vbase), v1 = vtr(vbase + 2048);
                    bf16x8 vf; vf[0] = v0[0]; vf[1] = v0[1]; vf[2] = v0[2]; vf[3] = v0[3]; vf[4] = v1[0]; vf[5] = v1[1]; vf[6] = v1[2]; vf[7] = v1[3]; return vf; };
                bf16x8 va0 = vfrag(0, 0), va1 = vfrag(0, 1), va2 = vfrag(0, 2), va3 = vfrag(0, 3), vb0, vb1, vb2, vb3;
                auto ppack = [&](int sp) { const int kb = sp >> 1, s2 = sp & 1; u32x4 pw; pw.x = cvt_pk(sacc[kb][8 * s2 + 0], sacc[kb][8 * s2 + 1]); pw.y = cvt_pk(sacc[kb][8 * s2 + 2], sacc[kb][8 * s2 + 3]);
                    pw.z = cvt_pk(sacc[kb][8 * s2 + 4], sacc[kb][8 * s2 + 5]); pw.w = cvt_pk(sacc[kb][8 * s2 + 6], sacc[kb][8 * s2 + 7]); return __builtin_bit_cast(bf16x8, pw); };
#pragma unroll
                for (int sp = 0; sp < 4; sp += 2) {
                    vb0 = vfrag(sp + 1, 0); vb1 = vfrag(sp + 1, 1); vb2 = vfrag(sp + 1, 2); vb3 = vfrag(sp + 1, 3);
                    asm volatile("" : "+v"(va0), "+v"(va1), "+v"(va2), "+v"(va3) :: "memory");
                    { const bf16x8 pf = ppack(sp);
                      oacc[0] = __builtin_amdgcn_mfma_f32_32x32x16_bf16(va0, pf, oacc[0], 0, 0, 0); oacc[1] = __builtin_amdgcn_mfma_f32_32x32x16_bf16(va1, pf, oacc[1], 0, 0, 0);
                      oacc[2] = __builtin_amdgcn_mfma_f32_32x32x16_bf16(va2, pf, oacc[2], 0, 0, 0); oacc[3] = __builtin_amdgcn_mfma_f32_32x32x16_bf16(va3, pf, oacc[3], 0, 0, 0); }
                    if (sp + 2 < 4) { va0 = vfrag(sp + 2, 0); va1 = vfrag(sp + 2, 1); va2 = vfrag(sp + 2, 2); va3 = vfrag(sp + 2, 3); }
                    asm volatile("" : "+v"(vb0), "+v"(vb1), "+v"(vb2), "+v"(vb3) :: "memory");
                    { const bf16x8 pf = ppack(sp + 1);
                      oacc[0] = __builtin_amdgcn_mfma_f32_32x32x16_bf16(vb0, pf, oacc[0], 0, 0, 0); oacc[1] = __builtin_amdgcn_mfma_f32_32x32x16_bf16(vb1, pf, oacc[1], 0, 0, 0);
                      oacc[2] = __builtin_amdgcn_mfma_f32_32x32x16_bf16(vb2, pf, oacc[2], 0, 0, 0); oacc[3] = __builtin_amdgcn_mfma_f32_32x32x16_bf16(vb3, pf, oacc[3], 0, 0, 0); }
                }
            }
        }
    }
    __syncthreads();

    if (MODE == 0) {
        const float inv = 1.f / (l_run + __shfl_xor(l_run, 32));
        bf16_t* op = MIX + (size_t)qrow * DM + 512 + 128 * h;
#pragma unroll
        for (int c = 0; c < 4; ++c)
#pragma unroll
            for (int g4 = 0; g4 < 4; ++g4) { u32x2 w; w.x = cvt_pk(oacc[c][4 * g4] * inv, oacc[c][4 * g4 + 1] * inv); w.y = cvt_pk(oacc[c][4 * g4 + 2] * inv, oacc[c][4 * g4 + 3] * inv);
                *(u32x2*)(op + 32 * c + 8 * g4 + 4 * hh) = w; }
    } else if (MODE == 1) {
        const float inv = 1.f / (l_run + __shfl_xor(l_run, 32));
        float* X = (float*)lds;
        if (map == 1) {
#pragma unroll
            for (int c = 0; c < 4; ++c)
#pragma unroll
                for (int g4 = 0; g4 < 4; ++g4) *(f32x4*)(X + (32 * wq + q32) * 132 + 32 * c + 8 * g4 + 4 * hh) =
                    (f32x4){oacc[c][4 * g4] * inv, oacc[c][4 * g4 + 1] * inv, oacc[c][4 * g4 + 2] * inv, oacc[c][4 * g4 + 3] * inv};
        }
        __syncthreads();
        if (map == 0) {
            float s1 = 0.f, s2 = 0.f;
#pragma unroll
            for (int j = 0; j < 64; ++j) { s1 += A->in[27][l * 64 + j] * A->in[28][l * 64 + j]; s2 += A->in[29][l * 64 + j] * A->in[30][l * 64 + j]; }
            const float lam_init = (l == 0) ? 0.2f : 0.35550906759096745f;
            const float lam = expf(s1) - expf(s2) + lam_init;
            float ss = 0.f;
#pragma unroll
            for (int c = 0; c < 4; ++c)
#pragma unroll
                for (int g4 = 0; g4 < 4; ++g4) { const f32x4 o2 = *(const f32x4*)(X + (32 * wq + q32) * 132 + 32 * c + 8 * g4 + 4 * hh);
#pragma unroll
                    for (int e = 0; e < 4; ++e) { const float o = oacc[c][4 * g4 + e] * inv - lam * o2[e]; oacc[c][4 * g4 + e] = o; ss += o * o; } }
            ss += __shfl_xor(ss, 32);
            const float r = (1.f / sqrtf(ss * (1.f / 128) + 1e-6f)) * (1.f - lam_init);
            bf16_t* op = MIX + (size_t)qrow * DM + 1536 + 128 * h; const float* sg = A->in[31] + l * 128;
            f32x4 sgv[4][4];
#pragma unroll
            for (int c = 0; c < 4; ++c)
#pragma unroll
                for (int g4 = 0; g4 < 4; ++g4) sgv[c][g4] = *(const f32x4*)(sg + 32 * c + 8 * g4 + 4 * hh);
#pragma unroll
            for (int c = 0; c < 4; ++c)
#pragma unroll
                for (int g4 = 0; g4 < 4; ++g4) { const int d = 32 * c + 8 * g4 + 4 * hh; const f32x4 g = sgv[c][g4];
                    u32x2 w; w.x = cvt_pk(oacc[c][4 * g4] * r * g[0], oacc[c][4 * g4 + 1] * r * g[1]); w.y = cvt_pk(oacc[c][4 * g4 + 2] * r * g[2], oacc[c][4 * g4 + 3] * r * g[3]);
                    *(u32x2*)(op + d) = w; }
        }
        __syncthreads();
    } else {
        float s = 0.f;
#pragma unroll
        for (int c = 0; c < 4; ++c)
#pragma unroll
            for (int i = 0; i < 16; ++i) s += oacc[c][i];
        s += __shfl_xor(s, 32);
        const float mu = s * (1.f / 128); float v = 0.f;
#pragma unroll
        for (int c = 0; c < 4; ++c)
#pragma unroll
            for (int i = 0; i < 16; ++i) { const float d = oacc[c][i] - mu; oacc[c][i] = d; v += d * d; }
        v += __shfl_xor(v, 32);
        const float r = 1.f / sqrtf(v * (1.f / 128) + 1e-5f);
        bf16_t* op = MIX + (size_t)qrow * DM + 1024 + 128 * h; const bf16_t* gp = PROJ + (size_t)qrow * INWP + C_RG + 128 * h;
        u32x2 gwv[4][4];
#pragma unroll
        for (int c = 0; c < 4; ++c)
#pragma unroll
            for (int g4 = 0; g4 < 4; ++g4) gwv[c][g4] = *(const u32x2*)(gp + 32 * c + 8 * g4 + 4 * hh);
#pragma unroll
        for (int c = 0; c < 4; ++c)
#pragma unroll
            for (int g4 = 0; g4 < 4; ++g4) { const int d = 32 * c + 8 * g4 + 4 * hh; const u32x2 gw = gwv[c][g4];
                const float g0 = bflo(gw.x), g1 = bfhi(gw.x), g2 = bflo(gw.y), g3 = bfhi(gw.y);
                u32x2 w; w.x = cvt_pk(oacc[c][4 * g4] * r * g0 * sigmoidf_(g0), oacc[c][4 * g4 + 1] * r * g1 * sigmoidf_(g1));
                w.y = cvt_pk(oacc[c][4 * g4 + 2] * r * g2 * sigmoidf_(g2), oacc[c][4 * g4 + 3] * r * g3 * sigmoidf_(g3));
                *(u32x2*)(op + d) = w; }
    }
}

#define XB_TMO      128
#define XB_XCNT(j)  (256  + 64 * (j))
#define XB_XSUB(j)  (1280 + 64 * (j))
#define XB_XGEN(j)  (2304 + 64 * (j))
#define XB_TOP      3328
#define XB_TOPGEN   3392
#define XCD_BAR_WORDS 3456
#define XB_SPIN_CAP (1u << 18)

__device__ __forceinline__ unsigned xb_ld(unsigned* p)              { return __hip_atomic_load(p, __ATOMIC_RELAXED, __HIP_MEMORY_SCOPE_AGENT); }
__device__ __forceinline__ unsigned xb_add(unsigned* p, unsigned v) { return __hip_atomic_fetch_add(p, v, __ATOMIC_RELAXED, __HIP_MEMORY_SCOPE_AGENT); }
__device__ __forceinline__ unsigned xb_xcc_id() { return (unsigned)__builtin_amdgcn_s_getreg((3 << 11) | 20) & 0xFu; }
#define XB_SPIN(cond, bar) do { unsigned _sp = 0; while (cond) { __builtin_amdgcn_s_sleep(1); \
    if ((++_sp & 255u) == 0u) { if (xb_ld(&(bar)[XB_TMO])) break; if (_sp > XB_SPIN_CAP) { atomicAdd(&(bar)[XB_TMO], 1u); break; } } } } while (0)

struct XcdBarrier {
    unsigned* bar; unsigned x;
    volatile LAS unsigned* st;
};

__device__ __forceinline__ XcdBarrier xcd_barrier_post(unsigned* bar, volatile LAS unsigned* st) {
    XcdBarrier b; b.bar = bar; b.x = xb_xcc_id(); b.st = st;
    if (threadIdx.x == 0) (void)xb_add(&bar[XB_XCNT(b.x)], 1u);
    return b;
}
__device__ __forceinline__ void xcd_barrier_complete(unsigned* bar, unsigned x, unsigned& nloc, unsigned& nx) {
    const unsigned G = gridDim.x * gridDim.y * gridDim.z;
    unsigned sum, cnt, mine, sp = 0u;
    for (;;) {
        sum = 0u; cnt = 0u; mine = 0u;
#pragma unroll
        for (unsigned j = 0; j < 16; ++j) { const unsigned c = xb_ld(&bar[XB_XCNT(j)]); sum += c; cnt += (c > 0u) ? 1u : 0u; mine = (j == x) ? c : mine; }
        if (sum == G) break;
        __builtin_amdgcn_s_sleep(1);
        if ((++sp & 255u) == 0u) { if (xb_ld(&bar[XB_TMO])) break; if (sp > XB_SPIN_CAP) { atomicAdd(&bar[XB_TMO], 1u); break; } }
    }
    nloc = mine > 0u ? mine : 1u; nx = cnt > 0u ? cnt : 1u;
}

__device__ __forceinline__ void xcd_barrier(const XcdBarrier& b) {
    asm volatile("s_waitcnt vmcnt(0)" ::: "memory");
    __syncthreads();
    if (threadIdx.x == 0) {
        unsigned* bar = b.bar;
        __builtin_amdgcn_s_waitcnt(0);
        unsigned nloc = b.st[0], nx = b.st[1];
        if (nloc == 0u) { xcd_barrier_complete(bar, b.x, nloc, nx); b.st[0] = nloc; b.st[1] = nx; }
        const unsigned old = xb_add(&bar[XB_XSUB(b.x)], 1u);
        const unsigned gen = old / nloc;
        if (old + 1u == (gen + 1u) * nloc) {
            __builtin_amdgcn_fence(__ATOMIC_RELEASE, "agent");
            asm volatile("s_waitcnt vmcnt(0)" ::: "memory");
            const unsigned og = xb_add(&bar[XB_TOP], 1u);
            const unsigned tg = og / nx;
            if (og + 1u == (tg + 1u) * nx) xb_add(&bar[XB_TOPGEN], 1u);
            else XB_SPIN(xb_ld(&bar[XB_TOPGEN]) == tg, bar);
            __builtin_amdgcn_fence(__ATOMIC_ACQUIRE, "agent");
            xb_add(&bar[XB_XGEN(b.x)], 1u);
            asm volatile("s_waitcnt vmcnt(0)" ::: "memory");
        } else {
            XB_SPIN(xb_ld(&bar[XB_XGEN(b.x)]) == gen, bar);
            __builtin_amdgcn_fence(__ATOMIC_ACQUIRE, "agent");
            asm volatile("s_waitcnt vmcnt(0)" ::: "memory");
        }
    }
    __syncthreads();
}


template <int PHM, int MIXM>
__global__ void __launch_bounds__(512, 2) mega(Args Aval) {
    const ArgsP kp = (ArgsP)__builtin_amdgcn_kernarg_segment_ptr();
    ArgsP A = launder(kp);
    extern __shared__ __attribute__((aligned(16))) unsigned char lds[];
    LAS unsigned char* ldsl = (LAS unsigned char*)lds;
    const int G = gridDim.x, bx = blockIdx.x;
#define FRESH() int tid = threadIdx.x; asm volatile("" : "+v"(tid)); const int lane = tid & 63, wave = __builtin_amdgcn_readfirstlane(tid >> 6), gw = bx * 8 + wave, ngw = G * 8; (void)lane; (void)gw; (void)ngw
    unsigned char* ws = A->ws;
    float* XF = A->out; bf16_t* XB = (bf16_t*)(ws + WS_XB);
    const int lo = A->ph_lo, hi = A->ph_hi;
    cg::grid_group grid = cg::this_grid();
    __shared__ int s_item;
    __shared__ unsigned s_bar[2];
    if (threadIdx.x < 2) s_bar[threadIdx.x] = 0u;
    __syncthreads();
    XcdBarrier xbar; xbar.bar = (unsigned*)(ws + WS_CTL) + 2048; xbar.x = 0; xbar.st = nullptr;
    if (hi - lo > 1) xbar = xcd_barrier_post((unsigned*)(ws + WS_CTL) + 2048, (volatile LAS unsigned*)s_bar);
#define IN(k) (lo <= (k) && (k) < hi)
#define SEAM(k) do { if (IN(k) && IN((k) + 1)) { xcd_barrier(xbar); if (PROBE_DUP & 4) { xcd_barrier(xbar); xcd_barrier(xbar); } } A = launder(kp); } while (0)
    if (hi > (1 << 20)) grid.sync();

    if ((PHM & 1) && IN(0)) { FRESH(); p0_prologue(A, lds, gw, ngw, lane, wave); if (PROBE_DUP & 8) { __syncthreads(); p0_prologue(A, lds, gw, ngw, lane, wave); } }
    SEAM(0);
    for (int l = 0; l < DEPTH; ++l) {
        const int pb = 1 + 12 * l;
        unsigned char* wl = ws + WS_W + (size_t)l * WL_SIZE;
        if ((PHM & 2) && IN(pb + 0)) {
          for (int rep = 0; rep < ((PROBE_DUP & 2) ? 2 : 1); ++rep)
            { pg8::Gemm g{XB, (const bf16_t*)(wl + WL_W1T), T, 2 * DFF, DM, DM}; pg8::StaticOrder S; S.init(T, 2 * DFF, G, bx);
              pg8::EpiSwiGLU E{(bf16_t*)(ws + WS_ACT), nullptr, nullptr, 44}; pg8::gemm_phase(ldsl, g, S, E); }
        }
        SEAM(pb + 0);
        for (int rp = 0; rp < ((PROBE_DUP & 256) ? 2 : 1); ++rp) if ((PHM & 4) && IN(pb + 1)) { pg8::Gemm g{(const bf16_t*)(ws + WS_ACT), (const bf16_t*)(wl + WL_W1D), T, DM, DFF, DFF}; pg8::StaticOrder S; S.init(T, DM, G, bx);
            pg8::EpiStore E{(bf16_t*)(ws + WS_MIX), DM, nullptr, 0, 0.5f}; pg8::gemm_phase(ldsl, g, S, E); }
        SEAM(pb + 1);
        if ((PHM & 8) && IN(pb + 2)) {
            { FRESH(); ln_phase(A->in[7] + l * DM, A->in[8] + l * DM, l ? nullptr : A->in[0], nullptr, XB, (bf16_t*)(ws + WS_XL), (const bf16_t*)(ws + WS_MIX), nullptr, gw, ngw, lane); }
        }
        SEAM(pb + 2);
        for (int rp = 0; rp < ((PROBE_DUP & 512) ? 2 : 1); ++rp) if ((PHM & 16) && IN(pb + 3)) { pg8::Gemm g{XB, (const bf16_t*)(wl + WL_WIN), T, INWP, DM, DM}; pg8::StaticOrder S; S.init(T, INWP, G, bx);
            pg8::EpiStore E{(bf16_t*)(ws + WS_PROJ), INWP, nullptr, 0, 1.f}; pg8::gemm_phase(ldsl, g, S, E); }
        if ((PHM & 16) && IN(pb + 3)) { pg8::Gemm g{(const bf16_t*)(ws + WS_PB) + (size_t)l * T * PLE, (const bf16_t*)(wl + WL_WPP), T, DM, PLE, PLE}; pg8::StaticOrder S;
            if (G == 256) S.init(T, DM, 192, bx >= 64 ? bx - 64 : (1 << 30)); else S.init(T, DM, G, bx);
            pg8::EpiStore E{(bf16_t*)(ws + WS_PP), DM, nullptr, 0, 1.f}; pg8::gemm_phase(ldsl, g, S, E); }
        SEAM(pb + 3);
        if ((PHM & 32) && IN(pb + 4)) {
            FRESH();
            for (int r = gw; r < T; r += 2 * ngw) {
                const int r1 = r + ngw;
                if (r1 < T) { PrepRegs R0, R1; prep_load(A, r, lane, R0); prep_load(A, r1, lane, R1); prep_finish(A, r, lane, R0); prep_finish(A, r1, lane, R1); }
                else { PrepRegs R0; prep_load(A, r, lane, R0); prep_finish(A, r, lane, R0); }
            }
            for (int it = gw; it < BATCH * 64 * 32; it += ngw) s5_local(A, l, it, lane, (float*)(lds + wave * 8448));
        }
        SEAM(pb + 4);
        if ((PHM & 64) && IN(pb + 5)) {
            { pg8::Gemm g{(const bf16_t*)(ws + WS_PROJ) + C_CKV, (const bf16_t*)(wl + WL_WUKV), T, 1024, 256, INWP}; pg8::StaticOrder S; S.init(T, 1024, G, bx);
              pg8::EpiStore E{(bf16_t*)(ws + WS_KVM), 1024, (const float*)(ws + WS_RSTD) + 1, 2, 1.f}; pg8::gemm_phase(ldsl, g, S, E); }
            { pg8::Gemm g{(const bf16_t*)(ws + WS_PROJ) + C_CQ, (const bf16_t*)(wl + WL_WUQ), T, 768, 512, INWP}; pg8::StaticOrder S; S.init(T, 768, G, bx);
              pg8::EpiStore E{(bf16_t*)(ws + WS_QM), 768, (const float*)(ws + WS_RSTD), 2, 1.f}; pg8::gemm_phase(ldsl, g, S, E); }
            { FRESH(); for (int it = ngw - 1 - gw; it < BATCH * 32; it += ngw) s5_prefix(A, l, it, lane); }
        }
        SEAM(pb + 5);
        if ((PHM & 128) && IN(pb + 6)) {
            FRESH();
          for (int rep = 0; rep < ((PROBE_DUP & 1) ? 2 : 1); ++rep) {
            unsigned* ctr = (unsigned*)(ws + WS_CTL) + 256 * l + 16 * rep;
#define QLOOP2(qi_, r2_, n_, ...) for (;;) { if (tid == 0) s_item = (int)atomicAdd(ctr + 64 * (qi_) + 32 * (r2_), 1u); __syncthreads(); const int item = s_item; __syncthreads(); if (item >= (n_)) break; __VA_ARGS__ }
            for (int r2 = 0; r2 < ((PROBE_DUP & 16) ? 2 : 1); ++r2) if (MIXM & 1) QLOOP2(0, r2, 256, { const int L = 15 - (item >> 4), r = item & 15; flash_unit<0>(A, l, r >> 2, r & 3, L, lds); })
            for (int r2 = 0; r2 < ((PROBE_DUP & 32) ? 2 : 1); ++r2) if (MIXM & 2) QLOOP2(1, r2, 256, { const int L = 15 - (item >> 4), r = item & 15; flash_unit<2>(A, l, r >> 2, r & 3, L, lds); })
            for (int r2 = 0; r2 < ((PROBE_DUP & 64) ? 2 : 1); ++r2) if (MIXM & 8) QLOOP2(2, r2, 256, { s5_unit(A, l, item, lds, wave, lane); })
            for (int r2 = 0; r2 < ((PROBE_DUP & 128) ? 2 : 1); ++r2) if (MIXM & 4) QLOOP2(3, r2, 512, { const int L = 31 - (item >> 4), r = item & 15; flash_unit<1>(A, l, r >> 2, r & 3, L, lds); })
#undef QLOOP2
          }
        }
        SEAM(pb + 6);
        for (int rp = 0; rp < ((PROBE_DUP & 256) ? 2 : 1); ++rp) if ((PHM & 256) && IN(pb + 7)) { pg8::Gemm g{(const bf16_t*)(ws + WS_MIX), (const bf16_t*)(wl + WL_WOUT), T, DM, DM, DM}; pg8::StaticOrder S; S.init(T, DM, G, bx);
            pg8::EpiStore E{(bf16_t*)(ws + WS_PROJ), DM, nullptr, 0, 1.0f}; pg8::gemm_phase(ldsl, g, S, E); }
        SEAM(pb + 7);
        if ((PHM & 512) && IN(pb + 8)) { FRESH(); ln_phase(A->in[11] + l * DM, A->in[12] + l * DM, nullptr, nullptr, XB, (bf16_t*)(ws + WS_XL), (const bf16_t*)(ws + WS_PROJ), nullptr, gw, ngw, lane); }
        SEAM(pb + 8);
        if ((PHM & 1024) && IN(pb + 9)) { pg8::Gemm g{XB, (const bf16_t*)(wl + WL_W2T), T, 2 * DFF + DM, DM, DM}; pg8::StaticOrder S; S.init(T, 2 * DFF + DM, G, bx);
            pg8::EpiSwiGLU E{(bf16_t*)(ws + WS_ACT), (bf16_t*)(ws + WS_PP), A->in[36] + l * DM, 44}; pg8::gemm_phase(ldsl, g, S, E); }
        SEAM(pb + 9);
        for (int rp = 0; rp < ((PROBE_DUP & 256) ? 2 : 1); ++rp) if ((PHM & 2048) && IN(pb + 10)) { pg8::Gemm g{(const bf16_t*)(ws + WS_ACT), (const bf16_t*)(wl + WL_W2D), T, DM, DFF, DFF}; pg8::StaticOrder S; S.init(T, DM, G, bx);
            pg8::EpiStore E{(bf16_t*)(ws + WS_MIX), DM, nullptr, 0, 0.5f}; pg8::gemm_phase(ldsl, g, S, E); }
        SEAM(pb + 10);
        if ((PHM & 4096) && IN(pb + 11)) { FRESH(); ln_phase(A->in[38] + l * DM, A->in[39] + l * DM, nullptr, l == DEPTH - 1 ? XF : nullptr, XB, (bf16_t*)(ws + WS_XL), (const bf16_t*)(ws + WS_MIX), (const bf16_t*)(ws + WS_PP), gw, ngw, lane); }
        SEAM(pb + 11);
    }
#undef IN
#undef SEAM
}

#ifndef FPHM
#define FPHM 0xFFFF
#endif
#ifndef FMIXM
#define FMIXM 15
#endif
#if ONE_LAUNCH
#define MEGA_MAIN mega<FPHM, FMIXM>
#else
#define MEGA_MAIN mega<1, 0>
#endif
extern "C" void kernel_launch(void* const* d_in, const int* in_sizes, int n_in, void* d_out, int out_size, void* d_ws, size_t ws_size, hipStream_t stream) {
    static int grid = 0;
    if (grid == 0) {
        if (n_in != 40 || out_size != T * DM || ws_size < WS_END) { fprintf(stderr, "kernel_launch: unexpected problem (n_in %d, out %d, ws %zu < %zu)\n", n_in, out_size, ws_size, (size_t)WS_END); grid = -1; return; }
        int dev = 0, cus = 0, per_cu = 0;
        hipGetDevice(&dev); hipDeviceGetAttribute(&cus, hipDeviceAttributeMultiprocessorCount, dev);
        if (hipFuncSetAttribute((const void*)MEGA_MAIN, hipFuncAttributeMaxDynamicSharedMemorySize, LDS_BYTES) != hipSuccess) { fprintf(stderr, "kernel_launch: hipFuncSetAttribute failed\n"); grid = -1; return; }
        if (hipOccupancyMaxActiveBlocksPerMultiprocessor(&per_cu, (const void*)MEGA_MAIN, 512, LDS_BYTES) != hipSuccess || per_cu < 1) { fprintf(stderr, "kernel_launch: occupancy query says %d\n", per_cu); per_cu = 1; }
        (void)hipGetLastError();
        grid = cus * 1;
    }
    if (grid < 0) return;
    hipMemsetAsync((char*)d_ws + WS_CTL, 0, CTL_BYTES, stream);
    Args a{};
    for (int i = 0; i < 40; ++i) a.in[i] = (const float*)d_in[i];
    a.out = (float*)d_out; a.ws = (unsigned char*)d_ws;
#if ONE_LAUNCH
    a.ph_lo = 0; a.ph_hi = NPH;
    void* args[] = {&a};
    hipError_t e = hipLaunchCooperativeKernel((const void*)MEGA_MAIN, dim3(grid), dim3(512), args, LDS_BYTES, stream);
    if (e != hipSuccess) fprintf(stderr, "cooperative launch failed: %s (grid %d)\n", hipGetErrorString(e), grid);
#else
#define LAUNCH(PHM_, MIXM_, ph_) do { static bool attr_done = false; if (!attr_done) { (void)hipFuncSetAttribute((const void*)mega<PHM_, MIXM_>, hipFuncAttributeMaxDynamicSharedMemorySize, LDS_BYTES); attr_done = true; } \
        a.ph_lo = (ph_); a.ph_hi = (ph_) + 1; hipLaunchKernelGGL((mega<PHM_, MIXM_>), dim3(grid), dim3(512), LDS_BYTES, stream, a); } while (0)
    LAUNCH(1, 0, 0);
    for (int l = 0; l < DEPTH; ++l) { const int pb = 1 + 12 * l;
        LAUNCH(2, 0, pb + 0); LAUNCH(4, 0, pb + 1); LAUNCH(8, 0, pb + 2); LAUNCH(16, 0, pb + 3); LAUNCH(32, 0, pb + 4); LAUNCH(64, 0, pb + 5);
        LAUNCH(128, 1, pb + 6); LAUNCH(128, 2, pb + 6); LAUNCH(128, 8, pb + 6); LAUNCH(128, 4, pb + 6);
        LAUNCH(256, 0, pb + 7); LAUNCH(512, 0, pb + 8); LAUNCH(1024, 0, pb + 9); LAUNCH(2048, 0, pb + 10); LAUNCH(4096, 0, pb + 11); }
#undef LAUNCH
#endif
}
```

```cpp
#include <hip/hip_runtime.h>
#include <hip/hip_cooperative_groups.h>
#include <cstdio>
#include <cstdint>
namespace cg = cooperative_groups;

#ifndef ONE_LAUNCH
#define ONE_LAUNCH 1
#endif

#ifndef PROBE_DUP
#define PROBE_DUP 0
#endif
#define LAS __attribute__((address_space(3)))
typedef unsigned short bf16_t;
typedef short bf16x8 __attribute__((ext_vector_type(8)));
typedef short s16x4 __attribute__((ext_vector_type(4)));
typedef float f32x4 __attribute__((ext_vector_type(4)));
typedef float f32x16 __attribute__((ext_vector_type(16)));
typedef unsigned u32x4 __attribute__((ext_vector_type(4)));
typedef unsigned u32x2 __attribute__((ext_vector_type(2)));
typedef float f32x2_t __attribute__((ext_vector_type(2)));
typedef __bf16 bf16x2_t __attribute__((ext_vector_type(2)));
typedef LAS const char* lds_cptr;

constexpr int BATCH = 4, SEQ = 4096, T = BATCH * SEQ, DM = 2048, DFF = 5632, DEPTH = 2, PLE = 256;
constexpr int INW = 4288, INWP = 4352;
constexpr int C_S5 = 0, C_CQ = 512, C_CKV = 1024, C_KR = 1152, C_RQ = 1216, C_RK = 1472, C_RV = 1728, C_RG = 2240, C_DQ = 2752, C_DK = 3264, C_DV = 3776;
constexpr float ALPHA = 1.41421356237309515f;
constexpr float LOG2E = 1.4426950408889634f;

__device__ __forceinline__ unsigned cvt_pk(float lo, float hi) { f32x2_t v = {lo, hi}; bf16x2_t b = __builtin_convertvector(v, bf16x2_t); return __builtin_bit_cast(unsigned, b); }
__device__ __forceinline__ float bf2f(unsigned short h) { return __uint_as_float(((unsigned)h) << 16); }
__device__ __forceinline__ float bflo(unsigned w) { return __uint_as_float(w << 16); }
__device__ __forceinline__ float bfhi(unsigned w) { return __uint_as_float(w & 0xffff0000u); }
__device__ __forceinline__ unsigned short f2bf(float f) { return (unsigned short)(cvt_pk(f, 0.f) & 0xffffu); }
__device__ __forceinline__ float wave_sum(float v) {
    v += __builtin_bit_cast(float, __builtin_amdgcn_update_dpp(0, __builtin_bit_cast(int, v), 0x111, 0xf, 0xf, true));
    v += __builtin_bit_cast(float, __builtin_amdgcn_update_dpp(0, __builtin_bit_cast(int, v), 0x112, 0xf, 0xf, true));
    v += __builtin_bit_cast(float, __builtin_amdgcn_update_dpp(0, __builtin_bit_cast(int, v), 0x114, 0xf, 0xf, true));
    v += __builtin_bit_cast(float, __builtin_amdgcn_update_dpp(0, __builtin_bit_cast(int, v), 0x118, 0xf, 0xf, true));
    v += __builtin_bit_cast(float, __builtin_amdgcn_update_dpp(0, __builtin_bit_cast(int, v), 0x142, 0xa, 0xf, false));
    v += __builtin_bit_cast(float, __builtin_amdgcn_update_dpp(0, __builtin_bit_cast(int, v), 0x143, 0xc, 0xf, false));
    return __builtin_bit_cast(float, __builtin_amdgcn_readlane(__builtin_bit_cast(int, v), 63));
}
__device__ __forceinline__ float fast_exp2(float x) { return __builtin_amdgcn_exp2f(x); }
__device__ __forceinline__ float fast_rcp(float x) { return __builtin_amdgcn_rcpf(x); }
__device__ __forceinline__ float sigmoidf_(float x) { return fast_rcp(1.f + fast_exp2(-x * LOG2E)); }

namespace pg8 {
constexpr int BM = 256, BK = 64, HALF = 128, HTB = HALF * BK * 2, STAGE_BYTES = 8 * HTB, NXCD = 8, WGM = 8;
__host__ __device__ __forceinline__ int lds_byte(int r, int c) { const int st = (r >> 4) * 2 + (c >> 5), rr = r & 15, cc = c & 31, ob = rr * 64 + cc * 2; return st * 1024 + (ob ^ (((ob >> 9) & 1) << 5)); }
__host__ __device__ __forceinline__ void stage_rc(int b, int& R, int& C) { const int st = b / 1024, sb = b % 1024, swz = sb ^ (((sb >> 9) & 1) << 5); R = (st >> 1) * 16 + swz / 64; C = (st & 1) * 32 + (swz % 64) / 2; }
__host__ __device__ __forceinline__ int perm32(int rho) { const int n = rho >> 4, i = rho & 15; return 8 * (i >> 2) + 4 * n + (i & 3); }
struct Unit { int pm, pn; };
struct Gemm { const bf16_t* A; const bf16_t* Bt; int M, N, K, lda; };
struct StaticOrder {
    int nM, nN, nwg, G, c;
    __device__ void init(int M, int N, int G_, int c_) { nM = M / BM; nN = N / BM; nwg = nM * nN; G = G_; c = c_; }
    __device__ bool next(int i, Unit& u) const {
        const long L = (long)i * G + c; if (L >= nwg) return false;
        int wgid = (int)L; { const int q = nwg / NXCD, r = nwg % NXCD, xcd = wgid % NXCD, off = wgid / NXCD; wgid = (xcd < r ? xcd * (q + 1) : r * (q + 1) + (xcd - r) * q) + off; }
        const int nig = WGM * nN, gid = wgid / nig, fm = gid * WGM, gsz = (nM - fm) < WGM ? (nM - fm) : WGM;
        u.pm = fm + ((wgid % nig) % gsz); u.pn = (wgid % nig) / gsz; return true;
    }
};

struct EpiStore {
    static constexpr bool PERM = true;
    bf16_t* O; int ldc; const float* rs; int rs_stride; float cs;
    __device__ __forceinline__ void operator()(const f32x4 (&acc)[2][2][4][2], const Unit& u, int wr, int wc, int fr, int fq) const {
        const int row0 = u.pm * BM + wr * 64 + fr, col0 = u.pn * BM + wc * 32 + 8 * fq;
        float scv[2][4];
#pragma unroll
        for (int ai = 0; ai < 2; ++ai)
#pragma unroll
            for (int m = 0; m < 4; ++m) scv[ai][m] = rs ? rs[(size_t)(row0 + ai * HALF + m * 16) * rs_stride] * cs : cs;
#pragma unroll
        for (int ai = 0; ai < 2; ++ai)
#pragma unroll
            for (int m = 0; m < 4; ++m) {
                const int row = row0 + ai * HALF + m * 16; const float sc = scv[ai][m];
                bf16_t* rowp = O + (size_t)row * ldc + col0;
#pragma unroll
                for (int bj = 0; bj < 2; ++bj) { const f32x4 v0 = acc[ai][bj][m][0] * sc, v1 = acc[ai][bj][m][1] * sc;
                    u32x4 w; w.x = cvt_pk(v0[0], v0[1]); w.y = cvt_pk(v0[2], v0[3]); w.z = cvt_pk(v1[0], v1[1]); w.w = cvt_pk(v1[2], v1[3]);
                    *(u32x4*)(rowp + bj * HALF) = w; }
            }
    }
};
struct EpiSwiGLU {
    static constexpr bool PERM = true;
    bf16_t* ACT; bf16_t* PP; const float* bg; int n_swi;
    __device__ __forceinline__ void operator()(const f32x4 (&acc)[2][2][4][2], const Unit& u, int wr, int wc, int fr, int fq) const {
        const int row0 = u.pm * BM + wr * 64 + fr;
        if (u.pn < n_swi) {
            const int col0 = u.pn * HALF + wc * 32 + 8 * fq;
#pragma unroll
            for (int ai = 0; ai < 2; ++ai)
#pragma unroll
                for (int m = 0; m < 4; ++m) {
                    const int row = row0 + ai * HALF + m * 16; float a[8];
#pragma unroll
                    for (int n = 0; n < 2; ++n)
#pragma unroll
                        for (int i = 0; i < 4; ++i) { const float g = acc[ai][0][m][n][i], up = acc[ai][1][m][n][i]; a[n * 4 + i] = g * sigmoidf_(g) * up; }
                    u32x4 w; w.x = cvt_pk(a[0], a[1]); w.y = cvt_pk(a[2], a[3]); w.z = cvt_pk(a[4], a[5]); w.w = cvt_pk(a[6], a[7]);
                    *(u32x4*)(ACT + (size_t)row * DFF + col0) = w;
                }
        } else {
            const int colb = (u.pn - n_swi) * BM + wc * 32 + 8 * fq;
            f32x4 bv[2][2];
#pragma unroll
            for (int bj = 0; bj < 2; ++bj) { bv[bj][0] = *(const f32x4*)(bg + colb + bj * HALF); bv[bj][1] = *(const f32x4*)(bg + colb + bj * HALF + 4); }
#pragma unroll
            for (int ai = 0; ai < 2; ++ai) {
                u32x4 ppv[4][2];
#pragma unroll
                for (int m = 0; m < 4; ++m)
#pragma unroll
                    for (int bj = 0; bj < 2; ++bj) ppv[m][bj] = *(const u32x4*)(PP + (size_t)(row0 + ai * HALF + m * 16) * DM + colb + bj * HALF);
#pragma unroll
                for (int m = 0; m < 4; ++m) {
                    const int row = row0 + ai * HALF + m * 16;
#pragma unroll
                    for (int bj = 0; bj < 2; ++bj) {
                        const int c = colb + bj * HALF; bf16_t* pq = PP + (size_t)row * DM + c;
                        const u32x4 pp = ppv[m][bj];
                        const f32x4 a0 = acc[ai][bj][m][0] + bv[bj][0], a1 = acc[ai][bj][m][1] + bv[bj][1];
                        u32x4 w; w.x = cvt_pk(sigmoidf_(a0[0]) * bflo(pp.x), sigmoidf_(a0[1]) * bfhi(pp.x)); w.y = cvt_pk(sigmoidf_(a0[2]) * bflo(pp.y), sigmoidf_(a0[3]) * bfhi(pp.y));
                        w.z = cvt_pk(sigmoidf_(a1[0]) * bflo(pp.z), sigmoidf_(a1[1]) * bfhi(pp.z)); w.w = cvt_pk(sigmoidf_(a1[2]) * bflo(pp.w), sigmoidf_(a1[3]) * bfhi(pp.w));
                        *(u32x4*)pq = w;
                    }
                }
            }
        }
    }
};
struct EpiRes {
    static constexpr bool PERM = false;
    float* XF; float a, s;
    __device__ __forceinline__ void operator()(const f32x4 (&acc)[2][2][4][2], const Unit& u, int wr, int wc, int fr, int fq) const {
        const int row0 = u.pm * BM + wr * 64 + fr, col0 = u.pn * BM + wc * 32 + 4 * fq;
#pragma unroll
        for (int ai = 0; ai < 2; ++ai)
#pragma unroll
            for (int m = 0; m < 4; ++m) {
                float* rp = XF + (size_t)(row0 + ai * HALF + m * 16) * DM + col0;
#pragma unroll
                for (int bj = 0; bj < 2; ++bj)
#pragma unroll
                    for (int n = 0; n < 2; ++n) { float* p = rp + bj * HALF + n * 16; f32x4 x = *(const f32x4*)p; x = x * a + acc[ai][bj][m][n] * s; *(f32x4*)p = x; }
            }
    }
};

#ifndef PG8_ALIGN
#define PG8_ALIGN true
#endif
template <class Epi, bool ALIGN_EPI = PG8_ALIGN>
__device__ __forceinline__ void gemm_phase(LAS unsigned char* lds, const Gemm g, const StaticOrder& S, const Epi& E) {
    int tid = threadIdx.x; asm volatile("" : "+v"(tid));
    const int wid = __builtin_amdgcn_readfirstlane(tid >> 6), lane = tid & 63, wr = wid >> 2, wc = wid & 3, fr = lane & 15, fq = lane >> 4;
    int K = g.K; asm volatile("" : "+s"(K)); const int nt = K / BK, lda = g.lda;
    unsigned voffA[2], voffB[2];
#pragma unroll
    for (int i = 0; i < 2; ++i) { int R, C; stage_rc(tid * 16 + i * 8192, R, C); const int Rb = Epi::PERM ? ((R & ~31) + perm32(R & 31)) : R;
        voffA[i] = (unsigned)(R * lda + C) * 2u; voffB[i] = (unsigned)(Rb * K + C) * 2u; }
    const size_t kstep = (size_t)(BK * 2);
    const size_t hstepA = (size_t)HALF * lda * 2, hstepB = (size_t)HALF * K * 2;
    const size_t tstepA = 2 * hstepA, tstepB = 2 * hstepB;
    const unsigned ldsw = (unsigned)wid * 1024u;
    const int aoff = lds_byte(wr * 64 + fr, fq * 8), boff = lds_byte(wc * 32 + fr, fq * 8);
#define PG8_SA(b, h) (((b) * 2 + (h)) * HTB)
#define PG8_SB(b, h) ((4 + (b) * 2 + (h)) * HTB)
#define PG8_STAGE(bufoff, gbase, voff) do { _Pragma("unroll") for (int _i = 0; _i < 2; ++_i) \
        __builtin_amdgcn_global_load_lds((const unsigned*)((const char*)(gbase) + (voff)[_i]), (LAS unsigned*)(lds + (bufoff) + ldsw + _i * 8192), 16, 0, 0); } while (0)
#define PG8_LDA(dst, b, h) do { _Pragma("unroll") for (int m = 0; m < 4; ++m) _Pragma("unroll") for (int k = 0; k < 2; ++k) dst[m][k] = *(const LAS bf16x8*)(lds + PG8_SA(b, h) + aoff + m * 2048 + k * 1024); } while (0)
#define PG8_LDB(dst, b, h) do { _Pragma("unroll") for (int n = 0; n < 2; ++n) _Pragma("unroll") for (int k = 0; k < 2; ++k) dst[n][k] = *(const LAS bf16x8*)(lds + PG8_SB(b, h) + boff + n * 2048 + k * 1024); } while (0)
#define PG8_MMA(ai, bj, At, Bt) do { __builtin_amdgcn_s_setprio(1); _Pragma("unroll") for (int m = 0; m < 4; ++m) _Pragma("unroll") for (int n = 0; n < 2; ++n) _Pragma("unroll") for (int k = 0; k < 2; ++k) \
        acc[ai][bj][m][n] = __builtin_amdgcn_mfma_f32_16x16x32_bf16(Bt[n][k], At[m][k], acc[ai][bj][m][n], 0, 0, 0); __builtin_amdgcn_s_setprio(0); } while (0)
#define PG8_WAIT_V(n) asm volatile("s_waitcnt vmcnt(" #n ")" ::: "memory")
#define PG8_WAIT_L(n) asm volatile("s_waitcnt lgkmcnt(" #n ")" ::: "memory")
#define PG8_BAR __builtin_amdgcn_s_barrier()
#define PG8_SCHED __builtin_amdgcn_sched_barrier(0)
    Unit cur, nxt; int ui = 0;
    if (!S.next(0, cur)) return;
    f32x4 acc[2][2][4][2];
#pragma unroll
    for (int a = 0; a < 2; ++a)
#pragma unroll
        for (int b = 0; b < 2; ++b)
#pragma unroll
            for (int m = 0; m < 4; ++m)
#pragma unroll
                for (int n = 0; n < 2; ++n) acc[a][b][m][n] = (f32x4){0.f, 0.f, 0.f, 0.f};
    bf16x8 At[4][2], B0[2][2], B1[2][2];
    const char* cA = (const char*)g.A + (size_t)cur.pm * tstepA; const char* cB = (const char*)g.Bt + (size_t)cur.pn * tstepB;
    PG8_STAGE(PG8_SB(0, 0), cB, voffB); PG8_STAGE(PG8_SB(0, 1), cB + hstepB, voffB); PG8_STAGE(PG8_SA(0, 0), cA, voffA); PG8_STAGE(PG8_SA(0, 1), cA + hstepA, voffA);
    if (wr == 1) PG8_BAR;
    PG8_WAIT_V(2); PG8_BAR;
    PG8_STAGE(PG8_SB(1, 0), cB + kstep, voffB); PG8_STAGE(PG8_SA(1, 0), cA + kstep, voffA); PG8_STAGE(PG8_SB(1, 1), cB + hstepB + kstep, voffB);
    PG8_WAIT_V(6); PG8_BAR;
    for (;;) {
        const bool has_next = S.next(ui + 1, nxt);
        const char* nA = has_next ? (const char*)g.A + (size_t)nxt.pm * tstepA : cA; const char* nB = has_next ? (const char*)g.Bt + (size_t)nxt.pn * tstepB : cB;
        for (int t = 0; t < nt; t += 2) {
            const bool last = (t == nt - 2);
            const char* a1 = cA + (size_t)(t + 1) * kstep;
            const char* a2 = last ? nA : cA + (size_t)(t + 2) * kstep; const char* b2 = last ? nB : cB + (size_t)(t + 2) * kstep;
            const char* a3 = a2 + kstep; const char* b3 = b2 + kstep;
            PG8_LDB(B0, 0, 0); PG8_LDB(B1, 0, 1); PG8_SCHED; PG8_LDA(At, 0, 0); PG8_STAGE(PG8_SA(1, 1), a1 + hstepA, voffA);
            PG8_WAIT_V(8); PG8_WAIT_L(0); PG8_BAR; PG8_MMA(0, 0, At, B0); PG8_MMA(0, 1, At, B1); PG8_BAR; PG8_SCHED;
            PG8_LDA(At, 0, 1); PG8_STAGE(PG8_SB(0, 0), b2, voffB); PG8_STAGE(PG8_SB(0, 1), b2 + hstepB, voffB); PG8_STAGE(PG8_SA(0, 0), a2, voffA);
            PG8_WAIT_V(8); PG8_WAIT_L(0); PG8_BAR; PG8_MMA(1, 0, At, B0); PG8_MMA(1, 1, At, B1); PG8_BAR; PG8_SCHED;
            PG8_LDB(B0, 1, 0); PG8_LDB(B1, 1, 1); PG8_SCHED; PG8_LDA(At, 1, 0); PG8_STAGE(PG8_SA(0, 1), a2 + hstepA, voffA);
            PG8_WAIT_V(8); PG8_WAIT_L(0); PG8_BAR; PG8_MMA(0, 0, At, B0); PG8_MMA(0, 1, At, B1); PG8_BAR; PG8_SCHED;
            PG8_LDA(At, 1, 1); PG8_STAGE(PG8_SB(1, 0), b3, voffB); PG8_STAGE(PG8_SB(1, 1), b3 + hstepB, voffB); PG8_STAGE(PG8_SA(1, 0), a3, voffA);
            PG8_WAIT_V(8); PG8_WAIT_L(0); PG8_BAR; PG8_MMA(1, 0, At, B0); PG8_MMA(1, 1, At, B1); PG8_BAR; PG8_SCHED;
        }
        if (ALIGN_EPI) { if (wr == 0) PG8_BAR; }
        E(acc, cur, wr, wc, fr, fq);
        if (!has_next) break;
#pragma unroll
        for (int a = 0; a < 2; ++a)
#pragma unroll
            for (int b = 0; b < 2; ++b)
#pragma unroll
                for (int m = 0; m < 4; ++m)
#pragma unroll
                    for (int n = 0; n < 2; ++n) acc[a][b][m][n] = (f32x4){0.f, 0.f, 0.f, 0.f};
        cur = nxt; cA = nA; cB = nB; ++ui;
        if (ALIGN_EPI) { if (wr == 1) PG8_BAR; }
    }
    PG8_WAIT_V(0);
    if (!ALIGN_EPI) { if (wr == 0) PG8_BAR; }
    PG8_BAR;
#undef PG8_SA
#undef PG8_SB
#undef PG8_STAGE
#undef PG8_LDA
#undef PG8_LDB
#undef PG8_MMA
#undef PG8_WAIT_V
#undef PG8_WAIT_L
#undef PG8_BAR
#undef PG8_SCHED
}
}

constexpr size_t al256(size_t x) { return (x + 255) & ~(size_t)255; }
constexpr size_t SZ_W1T = (size_t)2 * DFF * DM * 2, SZ_WD = (size_t)DM * DFF * 2, SZ_WIN = (size_t)INWP * DM * 2, SZ_WOUT = (size_t)DM * DM * 2;
constexpr size_t SZ_W2T = (size_t)(2 * DFF + DM) * DM * 2, SZ_WUQ = (size_t)768 * 512 * 2, SZ_WUKV = (size_t)1024 * 256 * 2, SZ_WGLU = (size_t)512 * 512 * 2, SZ_WPP = (size_t)DM * PLE * 2;
constexpr size_t WL_W1T = 0, WL_W1D = WL_W1T + SZ_W1T, WL_WIN = WL_W1D + SZ_WD, WL_WOUT = WL_WIN + SZ_WIN, WL_W2T = WL_WOUT + SZ_WOUT, WL_W2D = WL_W2T + SZ_W2T,
                 WL_WUQ = WL_W2D + SZ_WD, WL_WUKV = WL_WUQ + SZ_WUQ, WL_WGLU = WL_WUKV + SZ_WUKV, WL_WPP = WL_WGLU + SZ_WGLU, WL_SIZE = al256(WL_WPP + SZ_WPP);
constexpr size_t WS_CTL = 0, CTL_BYTES = 65536;
constexpr size_t WS_W = 65536;
constexpr size_t WS_XB = al256(WS_W + 2 * WL_SIZE);
constexpr size_t WS_U = al256(WS_XB + (size_t)T * DM * 2);
constexpr size_t WS_PROJ = WS_U, WS_QM = al256(WS_PROJ + (size_t)T * INWP * 2), WS_KVM = al256(WS_QM + (size_t)T * 768 * 2), WS_UEND = al256(WS_KVM + (size_t)T * 1024 * 2);
constexpr size_t WS_ACT = WS_U;
static_assert(WS_ACT + (size_t)T * DFF * 2 <= WS_UEND, "ACT overlays PROJ|QM|KVM");
constexpr size_t WS_MIX = WS_UEND;
constexpr size_t WS_PP = al256(WS_MIX + (size_t)T * DM * 2);
constexpr size_t WS_PB = al256(WS_PP + (size_t)T * DM * 2);
constexpr size_t WS_S5E = al256(WS_PB + (size_t)2 * T * PLE * 2);
constexpr size_t WS_RSTD = al256(WS_S5E + (size_t)BATCH * 64 * 32 * 64 * 2 * 4);
constexpr size_t WS_ROPE = al256(WS_RSTD + (size_t)T * 2 * 4);
constexpr size_t S5T_BYTES = 1024 + 8192 + 8192;
constexpr size_t WS_S5T = al256(WS_ROPE + (size_t)T * 64 * 4);
constexpr size_t WS_S5H = al256(WS_S5T + (size_t)DEPTH * 32 * S5T_BYTES);
constexpr size_t WS_XL = al256(WS_S5H + (size_t)BATCH * 64 * 32 * 64 * 2 * 4);
constexpr size_t WS_END = al256(WS_XL + (size_t)T * DM * 2);

constexpr int LDS_BYTES = 147456;
constexpr int NPH = 1 + 12 * DEPTH;

struct Args {
    const float* in[40]; float* out; unsigned char* ws; int ph_lo, ph_hi;
};
typedef const __attribute__((address_space(4))) Args* ArgsP;
__device__ __forceinline__ ArgsP launder(ArgsP p) { asm volatile("" : "+s"(p)); return p; }

__device__ __forceinline__ void sincos_d(double x, double& s, double& c) {
    const double k = rint(x * 0.15915494309189535);
    double r = fma(-k, 6.283185307179586, x); r = fma(-k, 2.4492935982947064e-16, r);
    const double y = r * 0.125, y2 = y * y;
    double sn = y * (1.0 + y2 * (-1.0 / 6 + y2 * (1.0 / 120 + y2 * (-1.0 / 5040 + y2 * (1.0 / 362880 + y2 * (-1.0 / 39916800 + y2 * (1.0 / 6227020800.0)))))));
    double cs = 1.0 + y2 * (-0.5 + y2 * (1.0 / 24 + y2 * (-1.0 / 720 + y2 * (1.0 / 40320 + y2 * (-1.0 / 3628800 + y2 * (1.0 / 479001600 + y2 * (-1.0 / 87178291200.0)))))));
#pragma unroll
    for (int i = 0; i < 3; ++i) { const double s2 = 2.0 * sn * cs, c2 = 1.0 - 2.0 * sn * sn; sn = s2; cs = c2; }
    s = sn; c = cs;
}
__device__ __forceinline__ double exp_d(double x) {
    const double k = rint(x * 1.4426950408889634);
    const double r = fma(-k, 0.6931471805599453, x) - k * 2.3190468138462996e-17;
    double p = 1.0 / 6227020800.0;
    p = p * r + 1.0 / 479001600; p = p * r + 1.0 / 39916800; p = p * r + 1.0 / 3628800; p = p * r + 1.0 / 362880; p = p * r + 1.0 / 40320; p = p * r + 1.0 / 5040;
    p = p * r + 1.0 / 720; p = p * r + 1.0 / 120; p = p * r + 1.0 / 24; p = p * r + 1.0 / 6; p = p * r + 0.5; p = p * r + 1.0; p = p * r + 1.0;
    const long long e = (long long)k + 1023; const double sc = __longlong_as_double(e << 52);
    return p * sc;
}

__device__ __forceinline__ void transpose_item(const float* __restrict__ W, int K, int N, bf16_t* WT, int ldk, int mode, int row_off, const float* ksc, float* scr, int item, int lane) {
    const int nblk = N / 32, kb = item / nblk, nb = item % nblk, k0 = 64 * kb, n0 = 32 * nb;
    const int drow = (mode == 0) ? (row_off + n0) : (256 * (n0 >> 7) + (n0 & 127) + row_off);
#pragma unroll
    for (int i = 0; i < 8; ++i) { const int kk = 8 * i + (lane >> 3), n4 = 4 * (lane & 7); f32x4 v = *(const f32x4*)(W + (size_t)(k0 + kk) * N + n0 + n4); if (ksc) v = v * ksc[k0 + kk];
        float* d = scr + kk * 33 + n4; d[0] = v[0]; d[1] = v[1]; d[2] = v[2]; d[3] = v[3]; }
    __builtin_amdgcn_wave_barrier(); asm volatile("s_waitcnt lgkmcnt(0)" ::: "memory");
    const int c = lane & 7;
#pragma unroll
    for (int j = 0; j < 4; ++j) { const int n = (lane >> 3) + 8 * j; const float* s = scr + (8 * c) * 33 + n;
        u32x4 o; o.x = cvt_pk(s[0 * 33], s[1 * 33]); o.y = cvt_pk(s[2 * 33], s[3 * 33]); o.z = cvt_pk(s[4 * 33], s[5 * 33]); o.w = cvt_pk(s[6 * 33], s[7 * 33]);
        *(u32x4*)(WT + (size_t)(drow + n) * ldk + k0 + 8 * c) = o; }
    __builtin_amdgcn_wave_barrier(); asm volatile("s_waitcnt lgkmcnt(0)" ::: "memory");
}

__device__ __forceinline__ void s5_table(ArgsP A, int l, int g, int lane, float* Hs);
__device__ __forceinline__ void p0_prologue(ArgsP A, unsigned char* lds, int gw, int ngw, int lane, int wave) {
    float* scr = (float*)(lds + wave * 16384);
    unsigned char* ws = A->ws;
    constexpr int I_FF = 32 * 176, I_IN = 32 * 134, I_SQ = 32 * 64, I_UQ = 8 * 24, I_UKV = 2 * 32, I_GLU = 8 * 16, I_PP = 4 * 64;
    constexpr int PER_L = 6 * I_FF + I_IN + 2 * I_SQ + I_UQ + I_UKV + I_GLU + I_PP;
    for (int it = gw; it < DEPTH * PER_L; it += ngw) {
        const int l = it / PER_L; int r = it % PER_L; unsigned char* wl = ws + WS_W + (size_t)l * WL_SIZE;
        if (r < I_FF) { transpose_item(A->in[4] + (size_t)l * DM * DFF, DM, DFF, (bf16_t*)(wl + WL_W1T), DM, 1, 0, nullptr, scr, r, lane); continue; } r -= I_FF;
        if (r < I_FF) { transpose_item(A->in[5] + (size_t)l * DM * DFF, DM, DFF, (bf16_t*)(wl + WL_W1T), DM, 1, 128, nullptr, scr, r, lane); continue; } r -= I_FF;
        if (r < I_FF) { transpose_item(A->in[6] + (size_t)l * DFF * DM, DFF, DM, (bf16_t*)(wl + WL_W1D), DFF, 0, 0, nullptr, scr, r, lane); continue; } r -= I_FF;
        if (r < I_IN) { transpose_item(A->in[9] + (size_t)l * DM * INW, DM, INW, (bf16_t*)(wl + WL_WIN), DM, 0, 0, nullptr, scr, r, lane); continue; } r -= I_IN;
        if (r < I_SQ) { transpose_item(A->in[10] + (size_t)l * DM * DM, DM, DM, (bf16_t*)(wl + WL_WOUT), DM, 0, 0, nullptr, scr, r, lane); continue; } r -= I_SQ;
        if (r < I_FF) { transpose_item(A->in[32] + (size_t)l * DM * DFF, DM, DFF, (bf16_t*)(wl + WL_W2T), DM, 1, 0, nullptr, scr, r, lane); continue; } r -= I_FF;
        if (r < I_FF) { transpose_item(A->in[33] + (size_t)l * DM * DFF, DM, DFF, (bf16_t*)(wl + WL_W2T), DM, 1, 128, nullptr, scr, r, lane); continue; } r -= I_FF;
        if (r < I_SQ) { transpose_item(A->in[35] + (size_t)l * DM * DM, DM, DM, (bf16_t*)(wl + WL_W2T), DM, 0, 2 * DFF, nullptr, scr, r, lane); continue; } r -= I_SQ;
        if (r < I_FF) { transpose_item(A->in[34] + (size_t)l * DFF * DM, DFF, DM, (bf16_t*)(wl + WL_W2D), DFF, 0, 0, nullptr, scr, r, lane); continue; } r -= I_FF;
        if (r < I_UQ) { transpose_item(A->in[24] + (size_t)l * 512 * 768, 512, 768, (bf16_t*)(wl + WL_WUQ), 512, 0, 0, A->in[23] + l * 512, scr, r, lane); continue; } r -= I_UQ;
        if (r < I_UKV) { transpose_item(A->in[26] + (size_t)l * 128 * 1024, 128, 1024, (bf16_t*)(wl + WL_WUKV), 256, 0, 0, A->in[25] + l * 128, scr, r, lane); continue; } r -= I_UKV;
        if (r < I_GLU) { transpose_item(A->in[21] + (size_t)l * 512 * 512, 512, 512, (bf16_t*)(wl + WL_WGLU), 512, 0, 0, nullptr, scr, r, lane); continue; } r -= I_GLU;
        transpose_item(A->in[37] + (size_t)l * PLE * DM, PLE, DM, (bf16_t*)(wl + WL_WPP), PLE, 0, 0, nullptr, scr, r, lane);
    }
    for (int it = ngw - 1 - gw; it < DEPTH * 32; it += ngw) s5_table(A, it >> 5, it & 31, lane, scr);
    const int gt = gw * 64 + lane, ngt = ngw * 64;
    for (int l = 0; l < DEPTH; ++l) {
        unsigned char* wl = ws + WS_W + (size_t)l * WL_SIZE;
        u32x4* z = (u32x4*)(wl + WL_WIN + (size_t)INW * DM * 2);
        for (int i = gt; i < 64 * DM * 2 / 16; i += ngt) z[i] = (u32x4){0u, 0u, 0u, 0u};
        for (int i = gt; i < 1024 * 16; i += ngt) { const int row = i >> 4, ch = i & 15; *(u32x4*)(wl + WL_WUKV + (size_t)row * 512 + 256 + ch * 16) = (u32x4){0u, 0u, 0u, 0u}; }
    }
    const float* x = A->in[0]; bf16_t* XB = (bf16_t*)(ws + WS_XB);
    for (int m = gw; m < T; m += ngw) {
        const float* xr = x + (size_t)m * DM + 8 * lane; bf16_t* ob = XB + (size_t)m * DM + 8 * lane;
#pragma unroll
        for (int j = 0; j < 4; ++j) { const f32x4 a = *(const f32x4*)(xr + 512 * j), c = *(const f32x4*)(xr + 512 * j + 4);
            u32x4 w; w.x = cvt_pk(a[0], a[1]); w.y = cvt_pk(a[2], a[3]); w.z = cvt_pk(c[0], c[1]); w.w = cvt_pk(c[2], c[3]); *(u32x4*)(ob + 512 * j) = w; }
    }
    { const f32x4* p4 = (const f32x4*)A->in[1]; u32x4* pb = (u32x4*)(ws + WS_PB);
      for (int i = gt; i < DEPTH * T * PLE / 8; i += ngt) { const f32x4 a = p4[2 * i], c = p4[2 * i + 1]; u32x4 w; w.x = cvt_pk(a[0], a[1]); w.y = cvt_pk(a[2], a[3]); w.z = cvt_pk(c[0], c[1]); w.w = cvt_pk(c[2], c[3]); pb[i] = w; } }
    { const int* pos = (const int*)A->in[2]; float* rp = (float*)(ws + WS_ROPE);
      for (int i = gt; i < T * 32; i += ngt) { const int row = i >> 5, j = i & 31; const double inv = exp_d(-(double)j * (9.210340371976184 / 32.0));
          double s, c; sincos_d((double)pos[row] * inv, s, c); rp[2 * i] = (float)c; rp[2 * i + 1] = (float)s; } }
}

__device__ __forceinline__ void ln_phase(const float* gam, const float* bet, const float* XIN, float* XFOUT, bf16_t* XB, bf16_t* XL, const bf16_t* HB, const bf16_t* GP, int gw, int ngw, int lane) {
    f32x4 gq[8], bq[8];
#pragma unroll
    for (int j = 0; j < 4; ++j) { const int col = 8 * lane + 512 * j; gq[2 * j] = *(const f32x4*)(gam + col); gq[2 * j + 1] = *(const f32x4*)(gam + col + 4); bq[2 * j] = *(const f32x4*)(bet + col); bq[2 * j + 1] = *(const f32x4*)(bet + col + 4); }
#pragma unroll
    for (int j = 0; j < 8; ++j) asm volatile("" : "+v"(gq[j]), "+v"(bq[j]));
    for (int m0 = gw; m0 < T; m0 += 2 * ngw) {
        const int m1 = (m0 + ngw < T) ? m0 + ngw : m0;
        f32x4 v[2][8]; float s[2] = {0.f, 0.f};
#pragma unroll
        for (int r = 0; r < 2; ++r) { const int m = r ? m1 : m0; const size_t ro = (size_t)m * DM + 8 * lane;
#pragma unroll
            for (int j = 0; j < 4; ++j) { f32x4 a, c;
                if (XIN) { a = *(const f32x4*)(XIN + ro + 512 * j); c = *(const f32x4*)(XIN + ro + 512 * j + 4); }
                else { const u32x4 xh = *(const u32x4*)(XB + ro + 512 * j); const u32x2 xl = *(const u32x2*)((const unsigned char*)XL + ro + 512 * j);
                    const f32x2_t l0 = __builtin_amdgcn_cvt_pk_f32_fp8((int)xl.x, false), l1 = __builtin_amdgcn_cvt_pk_f32_fp8((int)xl.x, true), l2 = __builtin_amdgcn_cvt_pk_f32_fp8((int)xl.y, false), l3 = __builtin_amdgcn_cvt_pk_f32_fp8((int)xl.y, true);
                    const float ls = 1.f / 512.f;
                    a = (f32x4){bflo(xh.x) + l0.x * ls, bfhi(xh.x) + l0.y * ls, bflo(xh.y) + l1.x * ls, bfhi(xh.y) + l1.y * ls};
                    c = (f32x4){bflo(xh.z) + l2.x * ls, bfhi(xh.z) + l2.y * ls, bflo(xh.w) + l3.x * ls, bfhi(xh.w) + l3.y * ls}; }
                const u32x4 h = *(const u32x4*)(HB + ro + 512 * j);
                a[0] = ALPHA * a[0] + bflo(h.x); a[1] = ALPHA * a[1] + bfhi(h.x); a[2] = ALPHA * a[2] + bflo(h.y); a[3] = ALPHA * a[3] + bfhi(h.y);
                c[0] = ALPHA * c[0] + bflo(h.z); c[1] = ALPHA * c[1] + bfhi(h.z); c[2] = ALPHA * c[2] + bflo(h.w); c[3] = ALPHA * c[3] + bfhi(h.w);
                if (GP) { const u32x4 q = *(const u32x4*)(GP + ro + 512 * j); a[0] += bflo(q.x); a[1] += bfhi(q.x); a[2] += bflo(q.y); a[3] += bfhi(q.y); c[0] += bflo(q.z); c[1] += bfhi(q.z); c[2] += bflo(q.w); c[3] += bfhi(q.w); }
                v[r][2 * j] = a; v[r][2 * j + 1] = c; s[r] += ((a[0] + a[1]) + (a[2] + a[3])) + ((c[0] + c[1]) + (c[2] + c[3])); } }
        float mean[2], s2[2] = {0.f, 0.f}, rstd[2];
#pragma unroll
        for (int r = 0; r < 2; ++r) mean[r] = wave_sum(s[r]) * (1.f / DM);
#pragma unroll
        for (int r = 0; r < 2; ++r)
#pragma unroll
            for (int j = 0; j < 8; ++j) { v[r][j] = v[r][j] - mean[r]; s2[r] += (v[r][j][0] * v[r][j][0] + v[r][j][1] * v[r][j][1]) + (v[r][j][2] * v[r][j][2] + v[r][j][3] * v[r][j][3]); }
#pragma unroll
        for (int r = 0; r < 2; ++r) rstd[r] = 1.f / sqrtf(wave_sum(s2[r]) * (1.f / DM) + 1e-5f);
#pragma unroll
        for (int r = 0; r < 2; ++r) { const int m = r ? m1 : m0; const size_t ro = (size_t)m * DM + 8 * lane;
#pragma unroll
            for (int j = 0; j < 4; ++j) {
                const f32x4 oa = v[r][2 * j] * rstd[r] * gq[2 * j] + bq[2 * j], oc = v[r][2 * j + 1] * rstd[r] * gq[2 * j + 1] + bq[2 * j + 1];
                u32x4 w; w.x = cvt_pk(oa[0], oa[1]); w.y = cvt_pk(oa[2], oa[3]); w.z = cvt_pk(oc[0], oc[1]); w.w = cvt_pk(oc[2], oc[3]); if (!XFOUT) *(u32x4*)(XB + ro + 512 * j) = w;
                int w0 = __builtin_amdgcn_cvt_pk_fp8_f32((oa[0] - bflo(w.x)) * 512.f, (oa[1] - bfhi(w.x)) * 512.f, 0, false); w0 = __builtin_amdgcn_cvt_pk_fp8_f32((oa[2] - bflo(w.y)) * 512.f, (oa[3] - bfhi(w.y)) * 512.f, w0, true);
                int w1 = __builtin_amdgcn_cvt_pk_fp8_f32((oc[0] - bflo(w.z)) * 512.f, (oc[1] - bfhi(w.z)) * 512.f, 0, false); w1 = __builtin_amdgcn_cvt_pk_fp8_f32((oc[2] - bflo(w.w)) * 512.f, (oc[3] - bfhi(w.w)) * 512.f, w1, true);
                if (!XFOUT) *(u32x2*)((unsigned char*)XL + ro + 512 * j) = (u32x2){(unsigned)w0, (unsigned)w1};
                if (XFOUT) { *(f32x4*)(XFOUT + ro + 512 * j) = oa; *(f32x4*)(XFOUT + ro + 512 * j + 4) = oc; } } }
    }
}

struct S5Coef { float ar, ai, aLr, aLi; float bbr[16], bbi[16]; };
__device__ __forceinline__ void s5_setup(ArgsP A, int l, int g, int p, S5Coef& C) {
    const int gi = (l * 32 + g) * 64 + p;
    const double lr = (double)A->in[13][gi], li = (double)A->in[14][gi], dt = exp_d((double)A->in[15][l * 32 + g]);
    const double mag = exp_d(lr * dt); double sn, cs; sincos_d(li * dt, sn, cs);
    const double ar = mag * cs, ai = mag * sn, den = lr * lr + li * li, am1 = ar - 1.0;
    const double fr = (am1 * lr + ai * li) / den, fi = (ai * lr - am1 * li) / den;
    const f32x4* br = (const f32x4*)(A->in[16] + (size_t)gi * 16); const f32x4* bi = (const f32x4*)(A->in[17] + (size_t)gi * 16);
#pragma unroll
    for (int q = 0; q < 4; ++q) { const f32x4 r4 = br[q], i4 = bi[q];
#pragma unroll
        for (int e = 0; e < 4; ++e) { C.bbr[q * 4 + e] = (float)(fr * r4[e] - fi * i4[e]); C.bbi[q * 4 + e] = (float)(fr * i4[e] + fi * r4[e]); } }
    double pr = ar, pi = ai;
#pragma unroll
    for (int i = 0; i < 6; ++i) { const double nr = pr * pr - pi * pi, ni = 2.0 * pr * pi; pr = nr; pi = ni; }
    C.ar = (float)ar; C.ai = (float)ai; C.aLr = (float)pr; C.aLi = (float)pi;
}
#define S5_LDS_FENCE() do { __builtin_amdgcn_wave_barrier(); asm volatile("s_waitcnt lgkmcnt(0)" ::: "memory"); } while (0)
__device__ __forceinline__ void s5_bmat(const S5Coef& C, float* Hs, int lane, bf16x8 (&bm)[8]) {
#pragma unroll
    for (int q = 0; q < 4; ++q) { *(f32x4*)(Hs + lane * 16 + 4 * q) = (f32x4){C.bbr[4 * q], C.bbr[4 * q + 1], C.bbr[4 * q + 2], C.bbr[4 * q + 3]};
                                  *(f32x4*)(Hs + (64 + lane) * 16 + 4 * q) = (f32x4){C.bbi[4 * q], C.bbi[4 * q + 1], C.bbi[4 * q + 2], C.bbi[4 * q + 3]}; }
    S5_LDS_FENCE();
    const int kq = lane >> 4;
#pragma unroll
    for (int nb = 0; nb < 8; ++nb) { const float* src = Hs + (16 * nb + (lane & 15)) * 16 + 8 * (kq & 1); const f32x4 v0 = *(const f32x4*)src, v1 = *(const f32x4*)(src + 4);
        float v[8] = {v0[0], v0[1], v0[2], v0[3], v1[0], v1[1], v1[2], v1[3]};
        if (kq >= 2) {
#pragma unroll
            for (int e = 0; e < 8; ++e) v[e] = v[e] - bf2f(f2bf(v[e])); }
        u32x4 w; w.x = cvt_pk(v[0], v[1]); w.y = cvt_pk(v[2], v[3]); w.z = cvt_pk(v[4], v[5]); w.w = cvt_pk(v[6], v[7]); bm[nb] = __builtin_bit_cast(bf16x8, w); }
    S5_LDS_FENCE();
}
__device__ __forceinline__ void s5_table(ArgsP A, int l, int g, int lane, float* Hs) {
    unsigned char* tb = A->ws + WS_S5T + (size_t)(l * 32 + g) * S5T_BYTES;
    S5Coef C; s5_setup(A, l, g, lane, C);
    bf16x8 bm[8]; s5_bmat(C, Hs, lane, bm);
    ((f32x4*)tb)[lane] = (f32x4){C.ar, C.ai, C.aLr, C.aLi};
#pragma unroll
    for (int nb = 0; nb < 8; ++nb) ((bf16x8*)(tb + 1024))[nb * 64 + lane] = bm[nb];
    const float* cre = A->in[18] + (size_t)((l * 32 + g) * 16 + (lane & 15)) * 64; const float* cim = A->in[19] + (size_t)((l * 32 + g) * 16 + (lane & 15)) * 64;
#pragma unroll
    for (int ks = 0; ks < 4; ++ks) { const float* src = (ks < 2 ? cre : cim) + 32 * (ks & 1) + 8 * (lane >> 4); const float sg = ks < 2 ? 1.f : -1.f;
        const f32x4 v0 = *(const f32x4*)src * sg, v1 = *(const f32x4*)(src + 4) * sg;
        u32x4 wh; wh.x = cvt_pk(v0[0], v0[1]); wh.y = cvt_pk(v0[2], v0[3]); wh.z = cvt_pk(v1[0], v1[1]); wh.w = cvt_pk(v1[2], v1[3]);
        u32x4 wl; wl.x = cvt_pk(v0[0] - bflo(wh.x), v0[1] - bfhi(wh.x)); wl.y = cvt_pk(v0[2] - bflo(wh.y), v0[3] - bfhi(wh.y)); wl.z = cvt_pk(v1[0] - bflo(wh.z), v1[1] - bfhi(wh.z)); wl.w = cvt_pk(v1[2] - bflo(wh.w), v1[3] - bfhi(wh.w));
        ((u32x4*)(tb + 9216))[(2 * ks) * 64 + lane] = wh; ((u32x4*)(tb + 9216))[(2 * ks + 1) * 64 + lane] = wl; }
}
__device__ __forceinline__ void s5_fetch(ArgsP A, int l, int g, int lane, S5Coef& C, bf16x8 (&bm)[8]) {
    const unsigned char* tb = A->ws + WS_S5T + (size_t)(l * 32 + g) * S5T_BYTES;
    const f32x4 c = ((const f32x4*)tb)[lane]; C.ar = c[0]; C.ai = c[1]; C.aLr = c[2]; C.aLi = c[3];
#pragma unroll
    for (int nb = 0; nb < 8; ++nb) bm[nb] = ((const bf16x8*)(tb + 1024))[nb * 64 + lane];
}
__device__ __forceinline__ u32x4 s5_load_ua(const bf16_t* PROJ, int row0, int g, int lane) { return *(const u32x4*)(PROJ + (size_t)(row0 + (lane & 15)) * INWP + C_S5 + 16 * g + 8 * ((lane >> 4) & 1)); }
template <bool WRITEH>
__device__ __forceinline__ void s5_block(const S5Coef& C, const bf16x8 (&bm)[8], u32x4 uw, float* Hs, int lane, float& hr, float& hi) {
    const bf16x8 ua = __builtin_bit_cast(bf16x8, uw);
#pragma unroll
    for (int nb = 0; nb < 8; ++nb) { const f32x4 d = __builtin_amdgcn_mfma_f32_16x16x32_bf16(ua, bm[nb], (f32x4){0.f, 0.f, 0.f, 0.f}, 0, 0, 0);
#pragma unroll
        for (int i = 0; i < 4; ++i) Hs[(4 * (lane >> 4) + i) * 132 + 16 * nb + (lane & 15)] = d[i]; }
    S5_LDS_FENCE();
    float bur[16], bui[16];
#pragma unroll
    for (int tl = 0; tl < 16; ++tl) { bur[tl] = Hs[tl * 132 + lane]; bui[tl] = Hs[tl * 132 + 64 + lane]; }
#pragma unroll
    for (int tl = 0; tl < 16; ++tl) { const float nr = C.ar * hr - C.ai * hi + bur[tl], ni = C.ar * hi + C.ai * hr + bui[tl]; hr = nr; hi = ni; bur[tl] = hr; bui[tl] = hi; }
    if (WRITEH) {
#pragma unroll
        for (int tl = 0; tl < 16; ++tl) { Hs[tl * 132 + lane] = bur[tl]; Hs[tl * 132 + 64 + lane] = bui[tl]; }
    }
    S5_LDS_FENCE();
}
__device__ __forceinline__ void s5_local(ArgsP A, int l, int item, int lane, float* Hs) {
    const int g = item & 31, c = (item >> 5) & 63, b = item >> 11;
    const bf16_t* PROJ = (const bf16_t*)(A->ws + WS_PROJ);
    u32x4 uw[4];
#pragma unroll
    for (int blk = 0; blk < 4; ++blk) uw[blk] = s5_load_ua(PROJ, b * SEQ + 64 * c + 16 * blk, g, lane);
    S5Coef C; bf16x8 bm[8]; s5_fetch(A, l, g, lane, C, bm);
    float hr = 0.f, hi = 0.f;
#pragma unroll
    for (int blk = 0; blk < 4; ++blk) s5_block<false>(C, bm, uw[blk], Hs, lane, hr, hi);
    f32x2_t* E = (f32x2_t*)(A->ws + WS_S5E); E[(size_t)((b * 64 + c) * 32 + g) * 64 + lane] = (f32x2_t){hr, hi};
}
__device__ __forceinline__ void s5_prefix(ArgsP A, int l, int item, int lane) {
    const int b = item >> 5, g = item & 31;
    const f32x4 cf = ((const f32x4*)(A->ws + WS_S5T + (size_t)(l * 32 + g) * S5T_BYTES))[lane]; const float aLr = cf[2], aLi = cf[3];
    const f32x2_t* E = (const f32x2_t*)(A->ws + WS_S5E); f32x2_t* H = (f32x2_t*)(A->ws + WS_S5H);
    float hr = 0.f, hi = 0.f;
    for (int c0 = 0; c0 < 64; c0 += 16) {
        f32x2_t e[16];
#pragma unroll
        for (int j = 0; j < 16; ++j) e[j] = E[(size_t)((b * 64 + c0 + j) * 32 + g) * 64 + lane];
#pragma unroll
        for (int j = 0; j < 16; ++j) { H[(size_t)((b * 64 + c0 + j) * 32 + g) * 64 + lane] = (f32x2_t){hr, hi};
            const float nr = aLr * hr - aLi * hi + e[j].x, ni = aLr * hi + aLi * hr + e[j].y; hr = nr; hi = ni; }
    }
}
__device__ __forceinline__ float gelu_tanh(float x) {
    const float z = 0.7978845608028654f * (x + 0.044715f * x * x * x);
    const float e = fast_exp2(2.f * z * LOG2E);
    const float th = 1.f - 2.f * fast_rcp(1.f + e);
    return 0.5f * x * (1.f + th);
}
constexpr int YS_STRIDE = 520;
__device__ __forceinline__ void s5_unit(ArgsP A, int l, int unit, unsigned char* lds, int wave_, int lane_) {
    int tid_ = threadIdx.x; asm volatile("" : "+v"(tid_)); const int lane = tid_ & 63, wave = __builtin_amdgcn_readfirstlane(tid_ >> 6);
    const int b = unit >> 6, c = unit & 63, rowbase = b * SEQ + 64 * c;
    const bf16_t* PROJ = (const bf16_t*)(A->ws + WS_PROJ);
    bf16_t* ys = (bf16_t*)lds;
    float* Hs = (float*)(lds + 66560 + wave * 8448);
    const f32x2_t* E = (const f32x2_t*)(A->ws + WS_S5E);
    for (int gi = 0; gi < 4; ++gi) {
        const int g = 4 * wave + gi;
        S5Coef C; bf16x8 bm[8]; s5_fetch(A, l, g, lane, C, bm);
        bf16x8 chl[8];
        { const bf16x8* ct = (const bf16x8*)(A->ws + WS_S5T + (size_t)(l * 32 + g) * S5T_BYTES + 9216);
#pragma unroll
          for (int q = 0; q < 8; ++q) chl[q] = ct[q * 64 + lane]; }
        const f32x2_t hin = ((const f32x2_t*)(A->ws + WS_S5H))[(size_t)((b * 64 + c) * 32 + g) * 64 + lane]; float hr = hin.x, hi = hin.y;
        u32x4 uw[4];
#pragma unroll
        for (int blk = 0; blk < 4; ++blk) uw[blk] = s5_load_ua(PROJ, rowbase + 16 * blk, g, lane);
        const float dv = A->in[20][l * 512 + 16 * g + (lane & 15)];
#pragma unroll
        for (int blk = 0; blk < 4; ++blk) {
            unsigned short uraw[4];
#pragma unroll
            for (int i = 0; i < 4; ++i) uraw[i] = PROJ[(size_t)(rowbase + 16 * blk + 4 * (lane >> 4) + i) * INWP + C_S5 + 16 * g + (lane & 15)];
            s5_block<true>(C, bm, uw[blk], Hs, lane, hr, hi);
            f32x4 y = (f32x4){0.f, 0.f, 0.f, 0.f}, y2 = (f32x4){0.f, 0.f, 0.f, 0.f};
#pragma unroll
            for (int ks = 0; ks < 4; ++ks) { const float* hp = Hs + (lane & 15) * 132 + 32 * ks + 8 * (lane >> 4); const f32x4 h0 = *(const f32x4*)hp, h1 = *(const f32x4*)(hp + 4);
                u32x4 wh; wh.x = cvt_pk(h0[0], h0[1]); wh.y = cvt_pk(h0[2], h0[3]); wh.z = cvt_pk(h1[0], h1[1]); wh.w = cvt_pk(h1[2], h1[3]);
                u32x4 wl; wl.x = cvt_pk(h0[0] - bflo(wh.x), h0[1] - bfhi(wh.x)); wl.y = cvt_pk(h0[2] - bflo(wh.y), h0[3] - bfhi(wh.y)); wl.z = cvt_pk(h1[0] - bflo(wh.z), h1[1] - bfhi(wh.z)); wl.w = cvt_pk(h1[2] - bflo(wh.w), h1[3] - bfhi(wh.w));
                const bf16x8 hh_ = __builtin_bit_cast(bf16x8, wh), hl_ = __builtin_bit_cast(bf16x8, wl);
                y = __builtin_amdgcn_mfma_f32_16x16x32_bf16(hh_, chl[2 * ks], y, 0, 0, 0); y2 = __builtin_amdgcn_mfma_f32_16x16x32_bf16(hh_, chl[2 * ks + 1], y2, 0, 0, 0);
                y2 = __builtin_amdgcn_mfma_f32_16x16x32_bf16(hl_, chl[2 * ks], y2, 0, 0, 0); }
            y = y + y2;
#pragma unroll
            for (int i = 0; i < 4; ++i) { const int t = 16 * blk + 4 * (lane >> 4) + i; const int col = 16 * g + (lane & 15);
                const float uval = bf2f(uraw[i]); const float v = gelu_tanh(y[i] + dv * uval); ys[t * YS_STRIDE + col] = f2bf(v); }
            __builtin_amdgcn_wave_barrier(); asm volatile("s_waitcnt lgkmcnt(0)" ::: "memory");
        }
    }
    __syncthreads();
    const bf16_t* WG = (const bf16_t*)(A->ws + WS_W + (size_t)l * WL_SIZE + WL_WGLU);
    f32x4 acc[4][4];
#pragma unroll
    for (int mb = 0; mb < 4; ++mb)
#pragma unroll
        for (int nb = 0; nb < 4; ++nb) acc[mb][nb] = (f32x4){0.f, 0.f, 0.f, 0.f};
    {
        const bf16_t* wb = WG + (size_t)(64 * wave + (lane & 15)) * 512 + 8 * (lane >> 4);
        bf16x8 b0 = *(const bf16x8*)(wb), b1 = *(const bf16x8*)(wb + 16 * 512), b2 = *(const bf16x8*)(wb + 32 * 512), b3 = *(const bf16x8*)(wb + 48 * 512);
#pragma unroll
        for (int ks = 0; ks < 16; ++ks) {
            bf16x8 n0 = b0, n1 = b1, n2 = b2, n3 = b3;
            if (ks + 1 < 16) { n0 = *(const bf16x8*)(wb + 32 * (ks + 1)); n1 = *(const bf16x8*)(wb + 16 * 512 + 32 * (ks + 1)); n2 = *(const bf16x8*)(wb + 32 * 512 + 32 * (ks + 1)); n3 = *(const bf16x8*)(wb + 48 * 512 + 32 * (ks + 1)); }
            bf16x8 af[4];
#pragma unroll
            for (int mb = 0; mb < 4; ++mb) af[mb] = *(const bf16x8*)(ys + (16 * mb + (lane & 15)) * YS_STRIDE + 32 * ks + 8 * (lane >> 4));
            asm volatile("" : "+v"(b0), "+v"(b1), "+v"(b2), "+v"(b3) :: "memory");
#pragma unroll
            for (int mb = 0; mb < 4; ++mb) { acc[mb][0] = __builtin_amdgcn_mfma_f32_16x16x32_bf16(af[mb], b0, acc[mb][0], 0, 0, 0); acc[mb][1] = __builtin_amdgcn_mfma_f32_16x16x32_bf16(af[mb], b1, acc[mb][1], 0, 0, 0);
                acc[mb][2] = __builtin_amdgcn_mfma_f32_16x16x32_bf16(af[mb], b2, acc[mb][2], 0, 0, 0); acc[mb][3] = __builtin_amdgcn_mfma_f32_16x16x32_bf16(af[mb], b3, acc[mb][3], 0, 0, 0); }
            b0 = n0; b1 = n1; b2 = n2; b3 = n3;
        }
    }
    bf16_t* MIX = (bf16_t*)(A->ws + WS_MIX);
    float bglv[4];
#pragma unroll
    for (int nb = 0; nb < 4; ++nb) bglv[nb] = A->in[22][l * 512 + 64 * wave + 16 * nb + (lane & 15)];
#pragma unroll
    for (int nb = 0; nb < 4; ++nb) { const int n = 64 * wave + 16 * nb + (lane & 15); const float bgl = bglv[nb];
#pragma unroll
        for (int mb = 0; mb < 4; ++mb)
#pragma unroll
            for (int i = 0; i < 4; ++i) { const int t = 16 * mb + 4 * (lane >> 4) + i; const float yv = bf2f(ys[t * YS_STRIDE + n]);
                MIX[(size_t)(rowbase + t) * DM + n] = f2bf(yv * sigmoidf_(acc[mb][nb][i] + bgl)); } }
    __syncthreads();
}

struct PrepRegs { u32x4 q; unsigned kv; u32x4 xa, xb; f32x4 t0, t1, t2, t3; };
__device__ __forceinline__ void prep_load(ArgsP A, int row, int lane, PrepRegs& R) {
    const bf16_t* pr = (const bf16_t*)(A->ws + WS_PROJ) + (size_t)row * INWP; const float* rope = (const float*)(A->ws + WS_ROPE) + (size_t)row * 64;
    R.q = *(const u32x4*)(pr + C_CQ + 8 * lane); R.kv = *(const unsigned*)(pr + C_CKV + 2 * lane);
    const int ln = lane < 36 ? lane : 0; const int blk = ln >> 2, j0 = 8 * (ln & 3);
    const int base = (blk == 0) ? C_KR : (blk <= 4 ? C_RQ + 64 * (blk - 1) : C_RK + 64 * (blk - 5));
    R.xa = *(const u32x4*)(pr + base + j0); R.xb = *(const u32x4*)(pr + base + 32 + j0);
    const f32x4* cs = (const f32x4*)(rope + 2 * j0); R.t0 = cs[0]; R.t1 = cs[1]; R.t2 = cs[2]; R.t3 = cs[3];
}
__device__ __forceinline__ void prep_finish(ArgsP A, int row, int lane, const PrepRegs& R) {
    bf16_t* pr = (bf16_t*)(A->ws + WS_PROJ) + (size_t)row * INWP;
    { const u32x4 q = R.q; float s = 0.f;
      s += bflo(q.x) * bflo(q.x) + bfhi(q.x) * bfhi(q.x) + bflo(q.y) * bflo(q.y) + bfhi(q.y) * bfhi(q.y) + bflo(q.z) * bflo(q.z) + bfhi(q.z) * bfhi(q.z) + bflo(q.w) * bflo(q.w) + bfhi(q.w) * bfhi(q.w);
      const unsigned kv = R.kv; float s2 = bflo(kv) * bflo(kv) + bfhi(kv) * bfhi(kv);
      s = wave_sum(s); s2 = wave_sum(s2);
      if (lane == 0) { float* rs = (float*)(A->ws + WS_RSTD) + (size_t)row * 2; rs[0] = 1.f / sqrtf(s * (1.f / 512) + 1e-6f); rs[1] = 1.f / sqrtf(s2 * (1.f / 128) + 1e-6f); } }
    if (lane < 36) {
        const int blk = lane >> 2, j0 = 8 * (lane & 3);
        const int base = (blk == 0) ? C_KR : (blk <= 4 ? C_RQ + 64 * (blk - 1) : C_RK + 64 * (blk - 5));
        float sc = 1.f; if (blk >= 5) { const float lgk = log2f(1.f - exp2f(-5.f - (float)(blk - 5))); sc = 0.125f * fast_exp2(-lgk * (float)(row & 63)); }
        const u32x4 xa = R.xa, xb = R.xb; const f32x4 t0 = R.t0, t1 = R.t1, t2 = R.t2, t3 = R.t3;
        const float a[8] = {bflo(xa.x), bfhi(xa.x), bflo(xa.y), bfhi(xa.y), bflo(xa.z), bfhi(xa.z), bflo(xa.w), bfhi(xa.w)};
        const float bq[8] = {bflo(xb.x), bfhi(xb.x), bflo(xb.y), bfhi(xb.y), bflo(xb.z), bfhi(xb.z), bflo(xb.w), bfhi(xb.w)};
        const float cc[8] = {t0[0], t0[2], t1[0], t1[2], t2[0], t2[2], t3[0], t3[2]}, ss[8] = {t0[1], t0[3], t1[1], t1[3], t2[1], t2[3], t3[1], t3[3]};
        float oa[8], ob[8];
#pragma unroll
        for (int e = 0; e < 8; ++e) { oa[e] = (a[e] * cc[e] - bq[e] * ss[e]) * sc; ob[e] = (a[e] * ss[e] + bq[e] * cc[e]) * sc; }
        u32x4 wa, wb; wa.x = cvt_pk(oa[0], oa[1]); wa.y = cvt_pk(oa[2], oa[3]); wa.z = cvt_pk(oa[4], oa[5]); wa.w = cvt_pk(oa[6], oa[7]);
        wb.x = cvt_pk(ob[0], ob[1]); wb.y = cvt_pk(ob[2], ob[3]); wb.z = cvt_pk(ob[4], ob[5]); wb.w = cvt_pk(ob[6], ob[7]);
        *(u32x4*)(pr + base + j0) = wa; *(u32x4*)(pr + base + 32 + j0) = wb;
    }
}

__device__ __forceinline__ s16x4 vtr(lds_cptr p) { return __builtin_bit_cast(s16x4, __builtin_amdgcn_ds_read_tr16_b64_v4i16((LAS s16x4*)p)); }
__device__ __forceinline__ bf16x8 scale8(u32x4 v, float c) {
    u32x4 o; o.x = cvt_pk(bflo(v.x) * c, bfhi(v.x) * c); o.y = cvt_pk(bflo(v.y) * c, bfhi(v.y) * c); o.z = cvt_pk(bflo(v.z) * c, bfhi(v.z) * c); o.w = cvt_pk(bflo(v.w) * c, bfhi(v.w) * c);
    return __builtin_bit_cast(bf16x8, o);
}
__device__ __forceinline__ void glds16(const void* gsrc, unsigned lds_dst) { unsigned keep;
    asm volatile("s_mov_b32 %0, m0\n\ts_mov_b32 m0, %2\n\ts_nop 0\n\tglobal_load_lds_dwordx4 %1, off\n\ts_mov_b32 m0, %0" : "=&s"(keep) : "v"(gsrc), "s"(lds_dst) : "memory"); }
__device__ __forceinline__ void glds4(const void* gsrc, unsigned lds_dst) { unsigned keep;
    asm volatile("s_mov_b32 %0, m0\n\ts_mov_b32 m0, %2\n\ts_nop 0\n\tglobal_load_lds_dword %1, off\n\ts_mov_b32 m0, %0" : "=&s"(keep) : "v"(gsrc), "s"(lds_dst) : "memory"); }
__device__ __forceinline__ int wave_max_i32(int v) {
    int t;
    t = __builtin_amdgcn_update_dpp(v, v, 0x111, 0xf, 0xf, false); v = t > v ? t : v;
    t = __builtin_amdgcn_update_dpp(v, v, 0x112, 0xf, 0xf, false); v = t > v ? t : v;
    t = __builtin_amdgcn_update_dpp(v, v, 0x114, 0xf, 0xf, false); v = t > v ? t : v;
    t = __builtin_amdgcn_update_dpp(v, v, 0x118, 0xf, 0xf, false); v = t > v ? t : v;
    t = __builtin_amdgcn_update_dpp(v, v, 0x142, 0xa, 0xf, false); v = t > v ? t : v;
    t = __builtin_amdgcn_update_dpp(v, v, 0x143, 0xc, 0xf, false); v = t > v ? t : v;
    return __builtin_amdgcn_readlane(v, 63);
}
__device__ __forceinline__ float max_xor32(float v) {
    const unsigned u = __float_as_uint(v); const auto r = __builtin_amdgcn_permlane32_swap(u, u, false, false);
    return fmaxf(__uint_as_float(r[0]), __uint_as_float(r[1]));
}
__device__ __forceinline__ int crow(int i, int hh) { return (i & 3) + 8 * (i >> 2) + 4 * hh; }

template <int MODE> struct FA;
template <> struct FA<0> { static constexpr int DQK = 192, KCH = 24, QROWS = 256; };
template <> struct FA<1> { static constexpr int DQK = 64,  KCH = 16, QROWS = 128; };
template <> struct FA<2> { static constexpr int DQK = 64,  KCH = 8,  QROWS = 256; };

template <int MODE>
__device__ __forceinline__ void flash_unit(ArgsP A, int l, int b, int h, int qb, unsigned char* lds) {
    constexpr int DQK = FA<MODE>::DQK, KCH = FA<MODE>::KCH, QROWS = FA<MODE>::QROWS, NS = DQK / 16;
    constexpr int KBYTES = 64 * KCH * 16, VBYTES = 64 * 256;
    constexpr int NKI = KCH / 8;
    constexpr int NBUF = (MODE == 0) ? 2 : 4;
    constexpr int OPS = NKI + 2 + (MODE == 1 ? 1 : 0);
    constexpr int OFF_EXTRA = NBUF * (KBYTES + VBYTES);
    int tid = threadIdx.x; asm volatile("" : "+v"(tid));
    const int lane = tid & 63, wave = __builtin_amdgcn_readfirstlane(tid >> 6), q32 = lane & 31, hh = lane >> 5;
    const bf16_t* PROJ = (const bf16_t*)(A->ws + WS_PROJ); const bf16_t* QM = (const bf16_t*)(A->ws + WS_QM); const bf16_t* KVM = (const bf16_t*)(A->ws + WS_KVM);
    bf16_t* MIX = (bf16_t*)(A->ws + WS_MIX);
    const int rowbase = b * SEQ;
    const int wq = (MODE == 1) ? (wave & 3) : wave;
    const int map = (MODE == 1) ? (wave >> 2) : 0;
    const int qi = qb * QROWS + 32 * wq + q32;
    const int qrow = rowbase + qi;
    const int ntile = (qb * QROWS + QROWS) / 64;
    const int tlast = (qb * QROWS + 32 * wq + 31) / 64;
    int* kpos = (int*)(lds + OFF_EXTRA);
    float* btab = (float*)(lds + OFF_EXTRA + NBUF * 256);

    bf16x8 qf[NS];
    if (MODE == 0) {
        const float csc = 0.07216878364870322f * LOG2E;
        const bf16_t* qp = QM + (size_t)qrow * 768 + 192 * h + 8 * hh;
        u32x4 raw[NS];
#pragma unroll
        for (int s = 0; s < NS; ++s) raw[s] = *(const u32x4*)(qp + 16 * s);
#pragma unroll
        for (int s = 0; s < 8; ++s) qf[s] = scale8(raw[s], csc);
        const float* rope = (const float*)(A->ws + WS_ROPE) + (size_t)qrow * 64;
#pragma unroll
        for (int pr = 0; pr < 2; ++pr) {
            const u32x4 xa = raw[8 + pr], xb = raw[10 + pr]; const f32x4* cs = (const f32x4*)(rope + 2 * (16 * pr + 8 * hh));
            float a[8], bb[8], oa[8], ob[8];
            a[0] = bflo(xa.x); a[1] = bfhi(xa.x); a[2] = bflo(xa.y); a[3] = bfhi(xa.y); a[4] = bflo(xa.z); a[5] = bfhi(xa.z); a[6] = bflo(xa.w); a[7] = bfhi(xa.w);
            bb[0] = bflo(xb.x); bb[1] = bfhi(xb.x); bb[2] = bflo(xb.y); bb[3] = bfhi(xb.y); bb[4] = bflo(xb.z); bb[5] = bfhi(xb.z); bb[6] = bflo(xb.w); bb[7] = bfhi(xb.w);
#pragma unroll
            for (int jj = 0; jj < 4; ++jj) { const f32x4 t4 = cs[jj];
                oa[2 * jj] = (a[2 * jj] * t4[0] - bb[2 * jj] * t4[1]) * csc; ob[2 * jj] = (a[2 * jj] * t4[1] + bb[2 * jj] * t4[0]) * csc;
                oa[2 * jj + 1] = (a[2 * jj + 1] * t4[2] - bb[2 * jj + 1] * t4[3]) * csc; ob[2 * jj + 1] = (a[2 * jj + 1] * t4[3] + bb[2 * jj + 1] * t4[2]) * csc; }
            u32x4 wa, wb; wa.x = cvt_pk(oa[0], oa[1]); wa.y = cvt_pk(oa[2], oa[3]); wa.z = cvt_pk(oa[4], oa[5]); wa.w = cvt_pk(oa[6], oa[7]);
            wb.x = cvt_pk(ob[0], ob[1]); wb.y = cvt_pk(ob[2], ob[3]); wb.z = cvt_pk(ob[4], ob[5]); wb.w = cvt_pk(ob[6], ob[7]);
            qf[8 + pr] = __builtin_bit_cast(bf16x8, wa); qf[10 + pr] = __builtin_bit_cast(bf16x8, wb);
        }
    } else if (MODE == 1) {
        const float csc = 0.125f * LOG2E;
        const bf16_t* qp = PROJ + (size_t)qrow * INWP + C_DQ + 128 * h + 64 * map + 8 * hh;
#pragma unroll
        for (int s = 0; s < NS; ++s) qf[s] = scale8(*(const u32x4*)(qp + 16 * s), csc);
    } else {
        const bf16_t* qp = PROJ + (size_t)qrow * INWP + C_RQ + 64 * h + 8 * hh;
#pragma unroll
        for (int s = 0; s < NS; ++s) qf[s] = __builtin_bit_cast(bf16x8, *(const u32x4*)(qp + 16 * s));
    }
    int posq = 0, qmin = 0; float bfar = 0.f;
    if (MODE == 1) {
        const int* pos = (const int*)A->in[2];
        if (tid < 129) { int n = tid; int bucket;
            if (n < 16) bucket = n; else { const float nf = (float)n; int lg = 16 + (int)(logf(nf / 16.f) / 2.0794415416798357f * 16.f); bucket = lg < 31 ? lg : 31; }
            if (tid == 128) bucket = 31;
            btab[tid] = A->in[3][bucket * 4 + h] * LOG2E; }
        posq = pos[qrow];
        int mn = posq;
#pragma unroll
        for (int o = 1; o < 64; o <<= 1) { const int other = __shfl_xor(mn, o); mn = other < mn ? other : mn; }
        qmin = mn;
    }
    float lg2 = 0.f;
    if (MODE == 2) lg2 = log2f(1.f - exp2f(-5.f - (float)h));

    const unsigned lds0 = (unsigned)(uintptr_t)lds;
    int kbase[4];
#pragma unroll
    for (int bsel = 0; bsel < 4; ++bsel) { const int ch = 2 * bsel + hh + (MODE == 1 ? 8 * map : 0), xr = (MODE == 1) ? (q32 & 15) : ((q32 >> 1) & 7); kbase[bsel] = (q32 * KCH + (ch ^ xr)) * 16; }
    auto dma_tile = [&](int t) {
        const int kr0 = rowbase + 64 * t;
        const int slot = t % NBUF; const unsigned kb_ = lds0 + slot * KBYTES, vb_ = lds0 + NBUF * KBYTES + slot * VBYTES;
#pragma unroll
        for (int i = 0; i < NKI; ++i) { const int piece = wave + 8 * i, p = 64 * piece + lane, key = p / KCH, cs = p % KCH;
            const int ch = cs ^ (MODE == 1 ? (key & 15) : ((key >> 1) & 7)); const bf16_t* src;
            if (MODE == 0) src = (ch < 16) ? KVM + (size_t)(kr0 + key) * 1024 + 256 * h + 8 * ch : PROJ + (size_t)(kr0 + key) * INWP + C_KR + 8 * (ch - 16);
            else if (MODE == 1) src = PROJ + (size_t)(kr0 + key) * INWP + C_DK + 128 * h + 8 * ch;
            else src = PROJ + (size_t)(kr0 + key) * INWP + C_RK + 64 * h + 8 * ch;
            glds16(src, (unsigned)__builtin_amdgcn_readfirstlane(kb_ + piece * 1024)); }
#pragma unroll
        for (int i = 0; i < 2; ++i) { const int piece = wave + 8 * i, p = 64 * piece + lane, st = p >> 5, key = 8 * (st >> 2) + ((p & 31) >> 2), col = 32 * (st & 3) + 8 * (p & 3); const bf16_t* src;
            if (MODE == 0) src = KVM + (size_t)(kr0 + key) * 1024 + 256 * h + 128 + col;
            else if (MODE == 1) src = PROJ + (size_t)(kr0 + key) * INWP + C_DV + 128 * h + col;
            else src = PROJ + (size_t)(kr0 + key) * INWP + C_RV + 128 * h + col;
            glds16(src, (unsigned)__builtin_amdgcn_readfirstlane(vb_ + piece * 1024)); }
        if (MODE == 1) glds4((const int*)A->in[2] + rowbase + 64 * t + lane, (unsigned)__builtin_amdgcn_readfirstlane(lds0 + OFF_EXTRA + slot * 256));
    };

    f32x16 oacc[4];
#pragma unroll
    for (int c = 0; c < 4; ++c)
#pragma unroll
        for (int i = 0; i < 16; ++i) oacc[c][i] = 0.f;
    float m_run = -INFINITY, l_run = 0.f;

#pragma unroll
    for (int s_ = 0; s_ < NS; ++s_) asm volatile("" : "+v"(qf[s_]));
    asm volatile("" : "+v"(posq), "+v"(qmin), "+v"(lg2));
    __syncthreads();
#pragma unroll
    for (int i = 0; i < NBUF - 1; ++i) if (i < ntile) dma_tile(i);
    for (int t = 0; t < ntile; ++t) {
        {
            const int later = (ntile - 1 - t) < (NBUF - 2) ? (ntile - 1 - t) : (NBUF - 2);
            if (later <= 0) asm volatile("s_waitcnt vmcnt(0) lgkmcnt(0)\n\ts_barrier" ::: "memory");
            else if (later == 1) asm volatile("s_waitcnt vmcnt(%0) lgkmcnt(0)\n\ts_barrier" :: "n"(OPS) : "memory");
            else asm volatile("s_waitcnt vmcnt(%0) lgkmcnt(0)\n\ts_barrier" :: "n"(2 * OPS) : "memory");
        }
        if (t + NBUF - 1 < ntile) dma_tile(t + NBUF - 1);
        if (t <= tlast) {
            const int slot = t % NBUF; const unsigned char* kb_ = lds + slot * KBYTES; const unsigned char* vb_ = lds + NBUF * KBYTES + slot * VBYTES;
            f32x16 sacc[2];
#pragma unroll
            for (int kb = 0; kb < 2; ++kb)
#pragma unroll
                for (int i = 0; i < 16; ++i) sacc[kb][i] = 0.f;
            {
                const unsigned char* kbuf = kb_;
                auto kld = [&](int f) { const int s_ = f >> 1, kbb = f & 1; const int bsel = (MODE == 0) ? (s_ & 3) : s_, imm = ((MODE == 0) ? (s_ >> 2) * 128 : 0) + kbb * (32 * KCH * 16);
                    return *(const bf16x8*)(kbuf + kbase[bsel] + imm); };
                constexpr int NB = (2 * NS) / 4;
                bf16x8 ka0 = kld(0), ka1 = kld(1), ka2 = kld(2), ka3 = kld(3), kb0, kb1, kb2, kb3;
#pragma unroll
                for (int bt = 0; bt < NB; bt += 2) {
                    if (bt + 1 < NB) { kb0 = kld(4 * bt + 4); kb1 = kld(4 * bt + 5); kb2 = kld(4 * bt + 6); kb3 = kld(4 * bt + 7); }
                    asm volatile("" : "+v"(ka0), "+v"(ka1), "+v"(ka2), "+v"(ka3) :: "memory");
                    sacc[0] = __builtin_amdgcn_mfma_f32_32x32x16_bf16(ka0, qf[2 * bt], sacc[0], 0, 0, 0); sacc[1] = __builtin_amdgcn_mfma_f32_32x32x16_bf16(ka1, qf[2 * bt], sacc[1], 0, 0, 0);
                    sacc[0] = __builtin_amdgcn_mfma_f32_32x32x16_bf16(ka2, qf[2 * bt + 1], sacc[0], 0, 0, 0); sacc[1] = __builtin_amdgcn_mfma_f32_32x32x16_bf16(ka3, qf[2 * bt + 1], sacc[1], 0, 0, 0);
                    if (bt + 1 < NB) {
                        if (bt + 2 < NB) { ka0 = kld(4 * bt + 8); ka1 = kld(4 * bt + 9); ka2 = kld(4 * bt + 10); ka3 = kld(4 * bt + 11); }
                        asm volatile("" : "+v"(kb0), "+v"(kb1), "+v"(kb2), "+v"(kb3) :: "memory");
                        sacc[0] = __builtin_amdgcn_mfma_f32_32x32x16_bf16(kb0, qf[2 * bt + 2], sacc[0], 0, 0, 0); sacc[1] = __builtin_amdgcn_mfma_f32_32x32x16_bf16(kb1, qf[2 * bt + 2], sacc[1], 0, 0, 0);
                        sacc[0] = __builtin_amdgcn_mfma_f32_32x32x16_bf16(kb2, qf[2 * bt + 3], sacc[0], 0, 0, 0); sacc[1] = __builtin_amdgcn_mfma_f32_32x32x16_bf16(kb3, qf[2 * bt + 3], sacc[1], 0, 0, 0);
                    }
                }
            }
            const bool diag = (t == tlast);
            if (MODE == 2) {
                const float gq = fast_exp2(lg2 * (float)(qi - 64 * t));
                if (diag) {
                    asm volatile("" ::: "memory");
#pragma unroll
                    for (int kb = 0; kb < 2; ++kb)
#pragma unroll
                        for (int i = 0; i < 16; ++i) sacc[kb][i] = (64 * t + 32 * kb + crow(i, hh) > qi) ? 0.f : sacc[kb][i] * gq;
                } else {
#pragma unroll
                    for (int kb = 0; kb < 2; ++kb)
#pragma unroll
                        for (int i = 0; i < 16; ++i) sacc[kb][i] *= gq;
                }
            } else {
                float boff = 0.f;
                if (MODE == 1) {
                    const int* kp = kpos + slot * 64;
                    const int kmx = wave_max_i32(kp[lane]);
                    if (qmin - kmx >= 128) { boff = btab[128];
                    } else {
#pragma unroll
                        for (int kb = 0; kb < 2; ++kb)
#pragma unroll
                            for (int i = 0; i < 16; ++i) { int d = posq - kp[32 * kb + crow(i, hh)]; d = d < 0 ? 0 : (d > 128 ? 128 : d); sacc[kb][i] += btab[d]; }
                    }
                }
                if (diag) {
                    asm volatile("" ::: "memory");
#pragma unroll
                    for (int kb = 0; kb < 2; ++kb)
#pragma unroll
                        for (int i = 0; i < 16; ++i) if (64 * t + 32 * kb + crow(i, hh) > qi) sacc[kb][i] = -INFINITY;
                }
                float mx = sacc[0][0];
#pragma unroll
                for (int kb = 0; kb < 2; ++kb)
#pragma unroll
                    for (int i = 0; i < 16; ++i) mx = fmaxf(mx, sacc[kb][i]);
                mx = max_xor32(mx) + boff;
                if (__builtin_amdgcn_ballot_w64(mx > m_run + 6.0f) != 0ull) {
                    const float mnew = fmaxf(m_run, mx), alpha = fast_exp2(m_run - mnew);
                    m_run = mnew; l_run *= alpha;
#pragma unroll
                    for (int c = 0; c < 4; ++c)
#pragma unroll
                        for (int i = 0; i < 16; ++i) oacc[c][i] *= alpha;
                }
                const float msub = m_run - boff; const f32x2_t msub2 = {msub, msub}; f32x2_t rs2 = {0.f, 0.f};
#pragma unroll
                for (int kb = 0; kb < 2; ++kb)
#pragma unroll
                    for (int i = 0; i < 16; i += 2) { const f32x2_t d = (f32x2_t){sacc[kb][i], sacc[kb][i + 1]} - msub2; f32x2_t p; p.x = fast_exp2(d.x); p.y = fast_exp2(d.y);
                        sacc[kb][i] = p.x; sacc[kb][i + 1] = p.y; rs2 = rs2 + p; }
                l_run += rs2.x + rs2.y;
            }
            {
                const lds_cptr vlane = (lds_cptr)vb_ + (4 * hh + ((lane & 15) >> 2)) * 64 + 32 * ((lane >> 4) & 1) + 8 * (lane & 3);
                auto vfrag = [&](int sp, int c) { const lds_cptr vbase = vlane + (4 * (sp >> 1) + 2 * (sp & 1)) * 2048 + c * 512;
                    const s16x4 v0 = vtr(vbase), v1 = vtr(vbase + 2048);
                    bf16x8 vf; vf[0] = v0[0]; vf[1] = v0[1]; vf[2] = v0[2]; vf[3] = v0[3]; vf[4] = v1[0]; vf[5] = v1[1]; vf[6] = v1[2]; vf[7] = v1[3]; return vf; };
                bf16x8 va0 = vfrag(0, 0), va1 = vfrag(0, 1), va2 = vfrag(0, 2), va3 = vfrag(0, 3), vb0, vb1, vb2, vb3;
                auto ppack = [&](int sp) { const int kb = sp >> 1, s2 = sp & 1; u32x4 pw; pw.x = cvt_pk(sacc[kb][8 * s2 + 0], sacc[kb][8 * s2 + 1]); pw.y = cvt_pk(sacc[kb][8 * s2 + 2], sacc[kb][8 * s2 + 3]);
                    pw.z = cvt_pk(sacc[kb][8 * s2 + 4], sacc[kb][8 * s2 + 5]); pw.w = cvt_pk(sacc[kb][8 * s2 + 6], sacc[kb][8 * s2 + 7]); return __builtin_bit_cast(bf16x8, pw); };
#pragma unroll
                for (int sp = 0; sp < 4; sp += 2) {
                    vb0 = vfrag(sp + 1, 0); vb1 = vfrag(sp + 1, 1); vb2 = vfrag(sp + 1, 2); vb3 = vfrag(sp + 1, 3);
                    asm volatile("" : "+v"(va0), "+v"(va1), "+v"(va2), "+v"(va3) :: "memory");
                    { const bf16x8 pf = ppack(sp);
                      oacc[0] = __builtin_amdgcn_mfma_f32_32x32x16_bf16(va0, pf, oacc[0], 0, 0, 0); oacc[1] = __builtin_amdgcn_mfma_f32_32x32x16_bf16(va1, pf, oacc[1], 0, 0, 0);
                      oacc[2] = __builtin_amdgcn_mfma_f32_32x32x16_bf16(va2, pf, oacc[2], 0, 0, 0); oacc[3] = __builtin_amdgcn_mfma_f32_32x32x16_bf16(va3, pf, oacc[3], 0, 0, 0); }
                    if (sp + 2 < 4) { va0 = vfrag(sp + 2, 0); va1 = vfrag(sp + 2, 1); va2 = vfrag(sp + 2, 2); va3 = vfrag(sp + 2, 3); }
                    asm volatile("" : "+v"(vb0), "+v"(vb1), "+v"(vb2), "+v"(vb3) :: "memory");
                    { const bf16x8 pf = ppack(sp + 1);
                      oacc[0] = __builtin_amdgcn_mfma_f32_32x32x16_bf16(vb0, pf, oacc[0], 0, 0, 0); oacc[1] = __builtin_amdgcn_mfma_f32_32x32x16_bf16(vb1, pf, oacc[1], 0, 0, 0);
                      oacc[2] = __builtin_amdgcn_mfma_f32_32x32x16_bf16(vb2, pf, oacc[2], 0, 0, 0); oacc[3] = __builtin_amdgcn_mfma_f32_32x32x16_bf16(vb3, pf, oacc[3], 0, 0, 0); }
                }
            }
        }
    }
    __syncthreads();

    if (MODE == 0) {
        const float inv = 1.f / (l_run + __shfl_xor(l_run, 32));
        bf16_t* op = MIX + (size_t)qrow * DM + 512 + 128 * h;
#pragma unroll
        for (int c = 0; c < 4; ++c)
#pragma unroll
            for (int g4 = 0; g4 < 4; ++g4) { u32x2 w; w.x = cvt_pk(oacc[c][4 * g4] * inv, oacc[c][4 * g4 + 1] * inv); w.y = cvt_pk(oacc[c][4 * g4 + 2] * inv, oacc[c][4 * g4 + 3] * inv);
                *(u32x2*)(op + 32 * c + 8 * g4 + 4 * hh) = w; }
    } else if (MODE == 1) {
        const float inv = 1.f / (l_run + __shfl_xor(l_run, 32));
        float* X = (float*)lds;
        if (map == 1) {
#pragma unroll
            for (int c = 0; c < 4; ++c)
#pragma unroll
                for (int g4 = 0; g4 < 4; ++g4) *(f32x4*)(X + (32 * wq + q32) * 132 + 32 * c + 8 * g4 + 4 * hh) =
                    (f32x4){oacc[c][4 * g4] * inv, oacc[c][4 * g4 + 1] * inv, oacc[c][4 * g4 + 2] * inv, oacc[c][4 * g4 + 3] * inv};
        }
        __syncthreads();
        if (map == 0) {
            float s1 = 0.f, s2 = 0.f;
#pragma unroll
            for (int j = 0; j < 64; ++j) { s1 += A->in[27][l * 64 + j] * A->in[28][l * 64 + j]; s2 += A->in[29][l * 64 + j] * A->in[30][l * 64 + j]; }
            const float lam_init = (l == 0) ? 0.2f : 0.35550906759096745f;
            const float lam = expf(s1) - expf(s2) + lam_init;
            float ss = 0.f;
#pragma unroll
            for (int c = 0; c < 4; ++c)
#pragma unroll
                for (int g4 = 0; g4 < 4; ++g4) { const f32x4 o2 = *(const f32x4*)(X + (32 * wq + q32) * 132 + 32 * c + 8 * g4 + 4 * hh);
#pragma unroll
                    for (int e = 0; e < 4; ++e) { const float o = oacc[c][4 * g4 + e] * inv - lam * o2[e]; oacc[c][4 * g4 + e] = o; ss += o * o; } }
            ss += __shfl_xor(ss, 32);
            const float r = (1.f / sqrtf(ss * (1.f / 128) + 1e-6f)) * (1.f - lam_init);
            bf16_t* op = MIX + (size_t)qrow * DM + 1536 + 128 * h; const float* sg = A->in[31] + l * 128;
            f32x4 sgv[4][4];
#pragma unroll
            for (int c = 0; c < 4; ++c)
#pragma unroll
                for (int g4 = 0; g4 < 4; ++g4) sgv[c][g4] = *(const f32x4*)(sg + 32 * c + 8 * g4 + 4 * hh);
#pragma unroll
            for (int c = 0; c < 4; ++c)
#pragma unroll
                for (int g4 = 0; g4 < 4; ++g4) { const int d = 32 * c + 8 * g4 + 4 * hh; const f32x4 g = sgv[c][g4];
                    u32x2 w; w.x = cvt_pk(oacc[c][4 * g4] * r * g[0], oacc[c][4 * g4 + 1] * r * g[1]); w.y = cvt_pk(oacc[c][4 * g4 + 2] * r * g[2], oacc[c][4 * g4 + 3] * r * g[3]);
                    *(u32x2*)(op + d) = w; }
        }
        __syncthreads();
    } else {
        float s = 0.f;
#pragma unroll
        for (int c = 0; c < 4; ++c)
#pragma unroll
            for (int i = 0; i < 16; ++i) s += oacc[c][i];
        s += __shfl_xor(s, 32);
        const float mu = s * (1.f / 128); float v = 0.f;
#pragma unroll
        for (int c = 0; c < 4; ++c)
#pragma unroll
            for (int i = 0; i < 16; ++i) { const float d = oacc[c][i] - mu; oacc[c][i] = d; v += d * d; }
        v += __shfl_xor(v, 32);
        const float r = 1.f / sqrtf(v * (1.f / 128) + 1e-5f);
        bf16_t* op = MIX + (size_t)qrow * DM + 1024 + 128 * h; const bf16_t* gp = PROJ + (size_t)qrow * INWP + C_RG + 128 * h;
        u32x2 gwv[4][4];
#pragma unroll
        for (int c = 0; c < 4; ++c)
#pragma unroll
            for (int g4 = 0; g4 < 4; ++g4) gwv[c][g4] = *(const u32x2*)(gp + 32 * c + 8 * g4 + 4 * hh);
#pragma unroll
        for (int c = 0; c < 4; ++c)
#pragma unroll
            for (int g4 = 0; g4 < 4; ++g4) { const int d = 32 * c + 8 * g4 + 4 * hh; const u32x2 gw = gwv[c][g4];
                const float g0 = bflo(gw.x), g1 = bfhi(gw.x), g2 = bflo(gw.y), g3 = bfhi(gw.y);
                u32x2 w; w.x = cvt_pk(oacc[c][4 * g4] * r * g0 * sigmoidf_(g0), oacc[c][4 * g4 + 1] * r * g1 * sigmoidf_(g1));
                w.y = cvt_pk(oacc[c][4 * g4 + 2] * r * g2 * sigmoidf_(g2), oacc[c][4 * g4 + 3] * r * g3 * sigmoidf_(g3));
                *(u32x2*)(op + d) = w; }
    }
}

#define XB_TMO      128
#define XB_XCNT(j)  (256  + 64 * (j))
#define XB_XSUB(j)  (1280 + 64 * (j))
#define XB_XGEN(j)  (2304 + 64 * (j))
#define XB_TOP      3328
#define XB_TOPGEN   3392
#define XCD_BAR_WORDS 3456
#define XB_SPIN_CAP (1u << 18)

__device__ __forceinline__ unsigned xb_ld(unsigned* p)              { return __hip_atomic_load(p, __ATOMIC_RELAXED, __HIP_MEMORY_SCOPE_AGENT); }
__device__ __forceinline__ unsigned xb_add(unsigned* p, unsigned v) { return __hip_atomic_fetch_add(p, v, __ATOMIC_RELAXED, __HIP_MEMORY_SCOPE_AGENT); }
__device__ __forceinline__ unsigned xb_xcc_id() { return (unsigned)__builtin_amdgcn_s_getreg((3 << 11) | 20) & 0xFu; }
#define XB_SPIN(cond, bar) do { unsigned _sp = 0; while (cond) { __builtin_amdgcn_s_sleep(1); \
    if ((++_sp & 255u) == 0u) { if (xb_ld(&(bar)[XB_TMO])) break; if (_sp > XB_SPIN_CAP) { atomicAdd(&(bar)[XB_TMO], 1u); break; } } } } while (0)

struct XcdBarrier {
    unsigned* bar; unsigned x;
    volatile LAS unsigned* st;
};

__device__ __forceinline__ XcdBarrier xcd_barrier_post(unsigned* bar, volatile LAS unsigned* st) {
    XcdBarrier b; b.bar = bar; b.x = xb_xcc_id(); b.st = st;
    if (threadIdx.x == 0) (void)xb_add(&bar[XB_XCNT(b.x)], 1u);
    return b;
}
__device__ __forceinline__ void xcd_barrier_complete(unsigned* bar, unsigned x, unsigned& nloc, unsigned& nx) {
    const unsigned G = gridDim.x * gridDim.y * gridDim.z;
    unsigned sum, cnt, mine, sp = 0u;
    for (;;) {
        sum = 0u; cnt = 0u; mine = 0u;
#pragma unroll
        for (unsigned j = 0; j < 16; ++j) { const unsigned c = xb_ld(&bar[XB_XCNT(j)]); sum += c; cnt += (c > 0u) ? 1u : 0u; mine = (j == x) ? c : mine; }
        if (sum == G) break;
        __builtin_amdgcn_s_sleep(1);
        if ((++sp & 255u) == 0u) { if (xb_ld(&bar[XB_TMO])) break; if (sp > XB_SPIN_CAP) { atomicAdd(&bar[XB_TMO], 1u); break; } }
    }
    nloc = mine > 0u ? mine : 1u; nx = cnt > 0u ? cnt : 1u;
}

__device__ __forceinline__ void xcd_barrier(const XcdBarrier& b) {
    asm volatile("s_waitcnt vmcnt(0)" ::: "memory");
    __syncthreads();
    if (threadIdx.x == 0) {
        unsigned* bar = b.bar;
        __builtin_amdgcn_s_waitcnt(0);
        unsigned nloc = b.st[0], nx = b.st[1];
        if (nloc == 0u) { xcd_barrier_complete(bar, b.x, nloc, nx); b.st[0] = nloc; b.st[1] = nx; }
        const unsigned old = xb_add(&bar[XB_XSUB(b.x)], 1u);
        const unsigned gen = old / nloc;
        if (old + 1u == (gen + 1u) * nloc) {
            __builtin_amdgcn_fence(__ATOMIC_RELEASE, "agent");
            asm volatile("s_waitcnt vmcnt(0)" ::: "memory");
            const unsigned og = xb_add(&bar[XB_TOP], 1u);
            const unsigned tg = og / nx;
            if (og + 1u == (tg + 1u) * nx) xb_add(&bar[XB_TOPGEN], 1u);
            else XB_SPIN(xb_ld(&bar[XB_TOPGEN]) == tg, bar);
            __builtin_amdgcn_fence(__ATOMIC_ACQUIRE, "agent");
            xb_add(&bar[XB_XGEN(b.x)], 1u);
            asm volatile("s_waitcnt vmcnt(0)" ::: "memory");
        } else {
            XB_SPIN(xb_ld(&bar[XB_XGEN(b.x)]) == gen, bar);
            __builtin_amdgcn_fence(__ATOMIC_ACQUIRE, "agent");
            asm volatile("s_waitcnt vmcnt(0)" ::: "memory");
        }
    }
    __syncthreads();
}


template <int PHM, int MIXM>
__global__ void __launch_bounds__(512, 2) mega(Args Aval) {
    const ArgsP kp = (ArgsP)__builtin_amdgcn_kernarg_segment_ptr();
    ArgsP A = launder(kp);
    extern __shared__ __attribute__((aligned(16))) unsigned char lds[];
    LAS unsigned char* ldsl = (LAS unsigned char*)lds;
    const int G = gridDim.x, bx = blockIdx.x;
#define FRESH() int tid = threadIdx.x; asm volatile("" : "+v"(tid)); const int lane = tid & 63, wave = __builtin_amdgcn_readfirstlane(tid >> 6), gw = bx * 8 + wave, ngw = G * 8; (void)lane; (void)gw; (void)ngw
    unsigned char* ws = A->ws;
    float* XF = A->out; bf16_t* XB = (bf16_t*)(ws + WS_XB);
    const int lo = A->ph_lo, hi = A->ph_hi;
    cg::grid_group grid = cg::this_grid();
    __shared__ int s_item;
    __shared__ unsigned s_bar[2];
    if (threadIdx.x < 2) s_bar[threadIdx.x] = 0u;
    __syncthreads();
    XcdBarrier xbar; xbar.bar = (unsigned*)(ws + WS_CTL) + 2048; xbar.x = 0; xbar.st = nullptr;
    if (hi - lo > 1) xbar = xcd_barrier_post((unsigned*)(ws + WS_CTL) + 2048, (volatile LAS unsigned*)s_bar);
#define IN(k) (lo <= (k) && (k) < hi)
#define SEAM(k) do { if (IN(k) && IN((k) + 1)) { xcd_barrier(xbar); if (PROBE_DUP & 4) { xcd_barrier(xbar); xcd_barrier(xbar); } } A = launder(kp); } while (0)
    if (hi > (1 << 20)) grid.sync();

    if ((PHM & 1) && IN(0)) { FRESH(); p0_prologue(A, lds, gw, ngw, lane, wave); if (PROBE_DUP & 8) { __syncthreads(); p0_prologue(A, lds, gw, ngw, lane, wave); } }
    SEAM(0);
    for (int l = 0; l < DEPTH; ++l) {
        const int pb = 1 + 12 * l;
        unsigned char* wl = ws + WS_W + (size_t)l * WL_SIZE;
        if ((PHM & 2) && IN(pb + 0)) {
          for (int rep = 0; rep < ((PROBE_DUP & 2) ? 2 : 1); ++rep)
            { pg8::Gemm g{XB, (const bf16_t*)(wl + WL_W1T), T, 2 * DFF, DM, DM}; pg8::StaticOrder S; S.init(T, 2 * DFF, G, bx);
              pg8::EpiSwiGLU E{(bf16_t*)(ws + WS_ACT), nullptr, nullptr, 44}; pg8::gemm_phase(ldsl, g, S, E); }
        }
        SEAM(pb + 0);
        for (int rp = 0; rp < ((PROBE_DUP & 256) ? 2 : 1); ++rp) if ((PHM & 4) && IN(pb + 1)) { pg8::Gemm g{(const bf16_t*)(ws + WS_ACT), (const bf16_t*)(wl + WL_W1D), T, DM, DFF, DFF}; pg8::StaticOrder S; S.init(T, DM, G, bx);
            pg8::EpiStore E{(bf16_t*)(ws + WS_MIX), DM, nullptr, 0, 0.5f}; pg8::gemm_phase(ldsl, g, S, E); }
        SEAM(pb + 1);
        if ((PHM & 8) && IN(pb + 2)) {
            { FRESH(); ln_phase(A->in[7] + l * DM, A->in[8] + l * DM, l ? nullptr : A->in[0], nullptr, XB, (bf16_t*)(ws + WS_XL), (const bf16_t*)(ws + WS_MIX), nullptr, gw, ngw, lane); }
        }
        SEAM(pb + 2);
        for (int rp = 0; rp < ((PROBE_DUP & 512) ? 2 : 1); ++rp) if ((PHM & 16) && IN(pb + 3)) { pg8::Gemm g{XB, (const bf16_t*)(wl + WL_WIN), T, INWP, DM, DM}; pg8::StaticOrder S; S.init(T, INWP, G, bx);
            pg8::EpiStore E{(bf16_t*)(ws + WS_PROJ), INWP, nullptr, 0, 1.f}; pg8::gemm_phase(ldsl, g, S, E); }
        if ((PHM & 16) && IN(pb + 3)) { pg8::Gemm g{(const bf16_t*)(ws + WS_PB) + (size_t)l * T * PLE, (const bf16_t*)(wl + WL_WPP), T, DM, PLE, PLE}; pg8::StaticOrder S;
            if (G == 256) S.init(T, DM, 192, bx >= 64 ? bx - 64 : (1 << 30)); else S.init(T, DM, G, bx);
            pg8::EpiStore E{(bf16_t*)(ws + WS_PP), DM, nullptr, 0, 1.f}; pg8::gemm_phase(ldsl, g, S, E); }
        SEAM(pb + 3);
        if ((PHM & 32) && IN(pb + 4)) {
            FRESH();
            for (int r = gw; r < T; r += 2 * ngw) {
                const int r1 = r + ngw;
                if (r1 < T) { PrepRegs R0, R1; prep_load(A, r, lane, R0); prep_load(A, r1, lane, R1); prep_finish(A, r, lane, R0); prep_finish(A, r1, lane, R1); }
                else { PrepRegs R0; prep_load(A, r, lane, R0); prep_finish(A, r, lane, R0); }
            }
            for (int it = gw; it < BATCH * 64 * 32; it += ngw) s5_local(A, l, it, lane, (float*)(lds + wave * 8448));
        }
        SEAM(pb + 4);
        if ((PHM & 64) && IN(pb + 5)) {
            { pg8::Gemm g{(const bf16_t*)(ws + WS_PROJ) + C_CKV, (const bf16_t*)(wl + WL_WUKV), T, 1024, 256, INWP}; pg8::StaticOrder S; S.init(T, 1024, G, bx);
              pg8::EpiStore E{(bf16_t*)(ws + WS_KVM), 1024, (const float*)(ws + WS_RSTD) + 1, 2, 1.f}; pg8::gemm_phase(ldsl, g, S, E); }
            { pg8::Gemm g{(const bf16_t*)(ws + WS_PROJ) + C_CQ, (const bf16_t*)(wl + WL_WUQ), T, 768, 512, INWP}; pg8::StaticOrder S; S.init(T, 768, G, bx);
              pg8::EpiStore E{(bf16_t*)(ws + WS_QM), 768, (const float*)(ws + WS_RSTD), 2, 1.f}; pg8::gemm_phase(ldsl, g, S, E); }
            { FRESH(); for (int it = ngw - 1 - gw; it < BATCH * 32; it += ngw) s5_prefix(A, l, it, lane); }
        }
        SEAM(pb + 5);
        if ((PHM & 128) && IN(pb + 6)) {
            FRESH();
          for (int rep = 0; rep < ((PROBE_DUP & 1) ? 2 : 1); ++rep) {
            unsigned* ctr = (unsigned*)(ws + WS_CTL) + 256 * l + 16 * rep;
#define QLOOP2(qi_, r2_, n_, ...) for (;;) { if (tid == 0) s_item = (int)atomicAdd(ctr + 64 * (qi_) + 32 * (r2_), 1u); __syncthreads(); const int item = s_item; __syncthreads(); if (item >= (n_)) break; __VA_ARGS__ }
            for (int r2 = 0; r2 < ((PROBE_DUP & 16) ? 2 : 1); ++r2) if (MIXM & 1) QLOOP2(0, r2, 256, { const int L = 15 - (item >> 4), r = item & 15; flash_unit<0>(A, l, r >> 2, r & 3, L, lds); })
            for (int r2 = 0; r2 < ((PROBE_DUP & 32) ? 2 : 1); ++r2) if (MIXM & 2) QLOOP2(1, r2, 256, { const int L = 15 - (item >> 4), r = item & 15; flash_unit<2>(A, l, r >> 2, r & 3, L, lds); })
            for (int r2 = 0; r2 < ((PROBE_DUP & 64) ? 2 : 1); ++r2) if (MIXM & 8) QLOOP2(2, r2, 256, { s5_unit(A, l, item, lds, wave, lane); })
            for (int r2 = 0; r2 < ((PROBE_DUP & 128) ? 2 : 1); ++r2) if (MIXM & 4) QLOOP2(3, r2, 512, { const int L = 31 - (item >> 4), r = item & 15; flash_unit<1>(A, l, r >> 2, r & 3, L, lds); })
#undef QLOOP2
          }
        }
        SEAM(pb + 6);
        for (int rp = 0; rp < ((PROBE_DUP & 256) ? 2 : 1); ++rp) if ((PHM & 256) && IN(pb + 7)) { pg8::Gemm g{(const bf16_t*)(ws + WS_MIX), (const bf16_t*)(wl + WL_WOUT), T, DM, DM, DM}; pg8::StaticOrder S; S.init(T, DM, G, bx);
            pg8::EpiStore E{(bf16_t*)(ws + WS_PROJ), DM, nullptr, 0, 1.0f}; pg8::gemm_phase(ldsl, g, S, E); }
        SEAM(pb + 7);
        if ((PHM & 512) && IN(pb + 8)) { FRESH(); ln_phase(A->in[11] + l * DM, A->in[12] + l * DM, nullptr, nullptr, XB, (bf16_t*)(ws + WS_XL), (const bf16_t*)(ws + WS_PROJ), nullptr, gw, ngw, lane); }
        SEAM(pb + 8);
        if ((PHM & 1024) && IN(pb + 9)) { pg8::Gemm g{XB, (const bf16_t*)(wl + WL_W2T), T, 2 * DFF + DM, DM, DM}; pg8::StaticOrder S; S.init(T, 2 * DFF + DM, G, bx);
            pg8::EpiSwiGLU E{(bf16_t*)(ws + WS_ACT), (bf16_t*)(ws + WS_PP), A->in[36] + l * DM, 44}; pg8::gemm_phase(ldsl, g, S, E); }
        SEAM(pb + 9);
        for (int rp = 0; rp < ((PROBE_DUP & 256) ? 2 : 1); ++rp) if ((PHM & 2048) && IN(pb + 10)) { pg8::Gemm g{(const bf16_t*)(ws + WS_ACT), (const bf16_t*)(wl + WL_W2D), T, DM, DFF, DFF}; pg8::StaticOrder S; S.init(T, DM, G, bx);
            pg8::EpiStore E{(bf16_t*)(ws + WS_MIX), DM, nullptr, 0, 0.5f}; pg8::gemm_phase(ldsl, g, S, E); }
        SEAM(pb + 10);
        if ((PHM & 4096) && IN(pb + 11)) { FRESH(); ln_phase(A->in[38] + l * DM, A->in[39] + l * DM, nullptr, l == DEPTH - 1 ? XF : nullptr, XB, (bf16_t*)(ws + WS_XL), (const bf16_t*)(ws + WS_MIX), (const bf16_t*)(ws + WS_PP), gw, ngw, lane); }
        SEAM(pb + 11);
    }
#undef IN
#undef SEAM
}

#ifndef FPHM
#define FPHM 0xFFFF
#endif
#ifndef FMIXM
#define FMIXM 15
#endif
#if ONE_LAUNCH
#define MEGA_MAIN mega<FPHM, FMIXM>
#else
#define MEGA_MAIN mega<1, 0>
#endif
extern "C" void kernel_launch(void* const* d_in, const int* in_sizes, int n_in, void* d_out, int out_size, void* d_ws, size_t ws_size, hipStream_t stream) {
    static int grid = 0;
    if (grid == 0) {
        if (n_in != 40 || out_size != T * DM || ws_size < WS_END) { fprintf(stderr, "kernel_launch: unexpected problem (n_in %d, out %d, ws %zu < %zu)\n", n_in, out_size, ws_size, (size_t)WS_END); grid = -1; return; }
        int dev = 0, cus = 0, per_cu = 0;
        hipGetDevice(&dev); hipDeviceGetAttribute(&cus, hipDeviceAttributeMultiprocessorCount, dev);
        if (hipFuncSetAttribute((const void*)MEGA_MAIN, hipFuncAttributeMaxDynamicSharedMemorySize, LDS_BYTES) != hipSuccess) { fprintf(stderr, "kernel_launch: hipFuncSetAttribute failed\n"); grid = -1; return; }
        if (hipOccupancyMaxActiveBlocksPerMultiprocessor(&per_cu, (const void*)MEGA_MAIN, 512, LDS_BYTES) != hipSuccess || per_cu < 1) { fprintf(stderr, "kernel_launch: occupancy query says %d\n", per_cu); per_cu = 1; }
        (void)hipGetLastError();
        grid = cus * 1;
    }
    if (grid < 0) return;
    hipMemsetAsync((char*)d_ws + WS_CTL, 0, CTL_BYTES, stream);
    Args a{};
    for (int i = 0; i < 40; ++i) a.in[i] = (const float*)d_in[i];
    a.out = (float*)d_out; a.ws = (unsigned char*)d_ws;
#if ONE_LAUNCH
    a.ph_lo = 0; a.ph_hi = NPH;
    void* args[] = {&a};
    hipError_t e = hipLaunchCooperativeKernel((const void*)MEGA_MAIN, dim3(grid), dim3(512), args, LDS_BYTES, stream);
    if (e != hipSuccess) fprintf(stderr, "cooperative launch failed: %s (grid %d)\n", hipGetErrorString(e), grid);
#else
#define LAUNCH(PHM_, MIXM_, ph_) do { static bool attr_done = false; if (!attr_done) { (void)hipFuncSetAttribute((const void*)mega<PHM_, MIXM_>, hipFuncAttributeMaxDynamicSharedMemorySize, LDS_BYTES); attr_done = true; } \
        a.ph_lo = (ph_); a.ph_hi = (ph_) + 1; hipLaunchKernelGGL((mega<PHM_, MIXM_>), dim3(grid), dim3(512), LDS_BYTES, stream, a); } while (0)
    LAUNCH(1, 0, 0);
    for (int l = 0; l < DEPTH; ++l) { const int pb = 1 + 12 * l;
        LAUNCH(2, 0, pb + 0); LAUNCH(4, 0, pb + 1); LAUNCH(8, 0, pb + 2); LAUNCH(16, 0, pb + 3); LAUNCH(32, 0, pb + 4); LAUNCH(64, 0, pb + 5);
        LAUNCH(128, 1, pb + 6); LAUNCH(128, 2, pb + 6); LAUNCH(128, 8, pb + 6); LAUNCH(128, 4, pb + 6);
        LAUNCH(256, 0, pb + 7); LAUNCH(512, 0, pb + 8); LAUNCH(1024, 0, pb + 9); LAUNCH(2048, 0, pb + 10); LAUNCH(4096, 0, pb + 11); }
#undef LAUNCH
#endif
}
```
